# Optimizing an MI355X kernel written in HIP

```python
import jax, jax.numpy as jnp
from jax import lax
import numpy as np

D_MODEL = 4096
BATCH = 2
SEQ = 8192
DEPTH = 1

N_HEADS = 16
N_KV_HEADS = 4
HEAD_DIM = 128
ATTN_WIDTH = N_HEADS * HEAD_DIM
KV_WIDTH = N_KV_HEADS * HEAD_DIM
IDX_HEADS = 16
IDX_DIM = 64
TOPK_MAX = 256
POOL_WINDOWS = (2, 4, 8, 16)
POOL_WIDTH = D_MODEL // 2
POOL_GROUP = POOL_WIDTH // len(POOL_WINDOWS)
MIX_WIDTH = ATTN_WIDTH + POOL_WIDTH
IN_SIZES = (ATTN_WIDTH, KV_WIDTH, KV_WIDTH, IDX_HEADS * IDX_DIM, IDX_DIM, IDX_HEADS, POOL_WIDTH)
IN_WIDTH = sum(IN_SIZES)
D_FF = -(-8 * D_MODEL // (3 * 256)) * 256
ROPE_THETA = 500000.0
ROT_FRACTION = 4
BLOCK_Q = 128
EPS = 1e-6

kernel_name = "hymba_style_dsa_pool_hybrid"


def rmsnorm(x, g):
    xf = x.astype(jnp.float32)
    y = xf * lax.rsqrt(jnp.mean(xf * xf, axis=-1, keepdims=True) + EPS)
    return (y * g.astype(jnp.float32)).astype(x.dtype)


def rope_tables(pos, rot_dim):
    inv_freq = ROPE_THETA ** (-jnp.arange(0, rot_dim, 2, dtype=jnp.float32) / rot_dim)
    ang = pos.astype(jnp.float32)[:, None] * inv_freq[None, :]
    return jnp.cos(ang), jnp.sin(ang)


def apply_partial_rope(x, cos, sin):
    rot = x.shape[-1] // ROT_FRACTION
    half = rot // 2
    xf = x.astype(jnp.float32)
    x1 = xf[..., :half]
    x2 = xf[..., half:rot]
    c = cos[:, None, :]
    s = sin[:, None, :]
    out = jnp.concatenate([x1 * c - x2 * s, x2 * c + x1 * s, xf[..., rot:]], axis=-1)
    return out.astype(x.dtype)


def dsa_sparse_attention(q, k, v, iq, ik, iw):
    B, S = q.shape[0], q.shape[1]
    topk = min(TOPK_MAX, S // 4)
    nb = S // BLOCK_Q
    group = N_HEADS // N_KV_HEADS
    scale = HEAD_DIM ** -0.5
    idx_scale = (IDX_DIM ** -0.5) * (IDX_HEADS ** -0.5)
    key_pos = jnp.arange(S)

    def to_blocks(a):
        return a.reshape((B, nb, BLOCK_Q) + a.shape[2:]).swapaxes(0, 1)

    qb, iqb, iwb = to_blocks(q), to_blocks(iq), to_blocks(iw)

    def block(args):
        blk, q_blk, iq_blk, iw_blk = args
        qpos = blk * BLOCK_Q + jnp.arange(BLOCK_Q)
        logits = jnp.einsum('bqhd,bsd->bqhs', iq_blk, ik).astype(jnp.float32)
        score = jnp.einsum('bqhs,bqh->bqs', jax.nn.relu(logits),
                           iw_blk.astype(jnp.float32)) * idx_scale
        causal = key_pos[None, :] <= qpos[:, None]
        score = jnp.where(causal[None], score, -jnp.inf)
        _, idx = lax.top_k(score, topk)
        valid = idx <= qpos[None, :, None]
        k_sel = jax.vmap(lambda kb, ib: kb[ib])(k, idx)
        v_sel = jax.vmap(lambda vb, ib: vb[ib])(v, idx)
        qg = q_blk.reshape(B, BLOCK_Q, N_KV_HEADS, group, HEAD_DIM)
        s = jnp.einsum('bqngd,bqknd->bqngk', qg, k_sel).astype(jnp.float32) * scale
        s = jnp.where(valid[:, :, None, None, :], s, -jnp.inf)
        p = jax.nn.softmax(s, axis=-1).astype(v.dtype)
        o = jnp.einsum('bqngk,bqknd->bqngd', p, v_sel)
        return o.reshape(B, BLOCK_Q, N_HEADS * HEAD_DIM)

    out = lax.map(block, (jnp.arange(nb), qb, iqb, iwb))
    return out.swapaxes(0, 1).reshape(B, S, N_HEADS * HEAD_DIM)


def multiscale_pool(u, w_pool, pool_scale):
    B, S, C = u.shape
    G = len(POOL_WINDOWS)
    uf = u.astype(jnp.float32)
    csum = jnp.cumsum(uf, axis=1)
    t = jnp.arange(S)
    pooled = []
    for g, w in enumerate(POOL_WINDOWS):
        cg = csum[..., g * POOL_GROUP:(g + 1) * POOL_GROUP]
        prev = jnp.pad(cg, ((0, 0), (w, 0), (0, 0)))[:, :S]
        cnt = jnp.minimum(t + 1, w).astype(jnp.float32)[None, :, None]
        pooled.append((cg - prev) / cnt)
    pooled = jnp.stack(pooled, axis=2)
    diff = (pooled - uf.reshape(B, S, G, POOL_GROUP)).astype(u.dtype)
    mixed = jnp.einsum('bsgc,gcd->bsgd', diff, w_pool)
    return mixed.reshape(B, S, C) * pool_scale


def setup_inputs(seed: int = 0) -> dict:
    key = jax.random.key(seed)
    ks = jax.random.split(key, 12)
    f32 = jnp.float32

    def dense(k, shape, fan_in):
        return jax.random.normal(k, shape, f32) * (fan_in ** -0.5)

    return {
        "x": jax.random.normal(ks[0], (BATCH, SEQ, D_MODEL), f32),
        "norm_mix_g": 1.0 + 0.02 * jax.random.normal(ks[1], (DEPTH, D_MODEL), f32),
        "w_in": dense(ks[2], (DEPTH, D_MODEL, IN_WIDTH), D_MODEL),
        "w_pool": dense(ks[3], (DEPTH, len(POOL_WINDOWS), POOL_GROUP, POOL_GROUP), POOL_GROUP),
        "pool_scale": 1.0 + 0.02 * jax.random.normal(ks[4], (DEPTH, POOL_WIDTH), f32),
        "w_out": dense(ks[5], (DEPTH, MIX_WIDTH, D_MODEL), MIX_WIDTH),
        "norm_ffn_g": 1.0 + 0.02 * jax.random.normal(ks[6], (DEPTH, D_MODEL), f32),
        "w_gate": dense(ks[7], (DEPTH, D_MODEL, D_FF), D_MODEL),
        "w_up": dense(ks[8], (DEPTH, D_MODEL, D_FF), D_MODEL),
        "w_down": dense(ks[9], (DEPTH, D_FF, D_MODEL), D_FF),
        "norm_final_g": 1.0 + 0.02 * jax.random.normal(ks[10], (D_MODEL,), f32),
    }


def reference(x, norm_mix_g, w_in, w_pool, pool_scale, w_out, norm_ffn_g,
              w_gate, w_up, w_down, norm_final_g):
    B, S, _ = x.shape
    pos = jnp.arange(S)
    cos_a, sin_a = rope_tables(pos, HEAD_DIM // ROT_FRACTION)
    cos_i, sin_i = rope_tables(pos, IDX_DIM // ROT_FRACTION)
    split_points = [int(v) for v in np.cumsum(IN_SIZES)[:-1]]
    for l in range(DEPTH):
        h = rmsnorm(x, norm_mix_g[l])
        z = jnp.einsum('bsd,de->bse', h, w_in[l])
        q, k, v, iq, ik, iw, u = jnp.split(z, split_points, axis=-1)
        q = apply_partial_rope(q.reshape(B, S, N_HEADS, HEAD_DIM), cos_a, sin_a)
        k = apply_partial_rope(k.reshape(B, S, N_KV_HEADS, HEAD_DIM), cos_a, sin_a)
        v = v.reshape(B, S, N_KV_HEADS, HEAD_DIM)
        iq = apply_partial_rope(iq.reshape(B, S, IDX_HEADS, IDX_DIM), cos_i, sin_i)
        ik = apply_partial_rope(ik.reshape(B, S, 1, IDX_DIM), cos_i, sin_i).reshape(B, S, IDX_DIM)
        attn = dsa_sparse_attention(q, k, v, iq, ik, iw)
        pool = multiscale_pool(u, w_pool[l], pool_scale[l])
        mixed = jnp.concatenate([attn, pool], axis=-1)
        x = x + jnp.einsum('bse,ed->bsd', mixed, w_out[l])
        h = rmsnorm(x, norm_ffn_g[l])
        a = jax.nn.silu(jnp.einsum('bsd,df->bsf', h, w_gate[l])) * jnp.einsum('bsd,df->bsf', h, w_up[l])
        x = x + jnp.einsum('bsf,fd->bsd', a, w_down[l])
    return rmsnorm(x, norm_final_g)
```

```cpp
#include <hip/hip_runtime.h>
#include <cstdio>
#include <cstdint>
#include <cmath>

#ifndef MK_N_LAUNCHES
#define MK_N_LAUNCHES 1
#endif

#ifndef PROBE_REP
#define PROBE_REP -1
#endif
#ifndef K_FP8
#define K_FP8 1
#endif
#ifndef V_FP8
#define V_FP8 1
#endif
#ifndef QKV_FP8
#define QKV_FP8 1
#endif
#ifndef OUT_FP8
#define OUT_FP8 1
#endif
#ifndef FFN_F8K
#define FFN_F8K 1
#endif
#ifndef POOL_FOLD
#define POOL_FOLD 1
#endif
#ifndef P2_CV_ROUNDS
#define P2_CV_ROUNDS 8
#endif
#ifndef GU_I8
#define GU_I8 1
#endif
#ifndef U_I8
#define U_I8 1
#endif
#ifndef QKV_I8
#define QKV_I8 1
#endif
#ifndef OUT_I8P
#define OUT_I8P 1
#endif
#ifndef FFN_BF16
#define FFN_BF16 1
#endif
#define LAS __attribute__((address_space(3)))
#define GAS __attribute__((address_space(1)))
typedef _Float16 f16;
typedef _Float16 f16x8 __attribute__((ext_vector_type(8)));
typedef _Float16 f16x4 __attribute__((ext_vector_type(4)));
typedef _Float16 f16x2 __attribute__((ext_vector_type(2)));
typedef float f32x4 __attribute__((ext_vector_type(4)));
typedef float f32x2 __attribute__((ext_vector_type(2)));
typedef float f32x16 __attribute__((ext_vector_type(16)));
typedef unsigned u32x4 __attribute__((ext_vector_type(4)));
typedef unsigned u32x2 __attribute__((ext_vector_type(2)));
typedef unsigned short u16;
typedef short bf16x8 __attribute__((ext_vector_type(8)));
typedef int i32x8 __attribute__((ext_vector_type(8)));
typedef int i32x4 __attribute__((ext_vector_type(4)));
typedef GAS unsigned gu32;

constexpr int SEQ = 8192, DM = 4096, M = 16384;
constexpr int NQ = 2048, NKV = 512, NIQ = 1024, NIK = 64, NIW = 16, NU = 2048, IN_W = 6224;
constexpr int NIN_T = 6400;
constexpr int DFF = 11008, NGU = 2 * DFF;
constexpr int TOPK = 256;
constexpr float EPS = 1e-6f;
constexpr int NWAVES = 8;

constexpr size_t MiB = 1u << 20;
constexpr size_t WS_CTL = 0, CTL_ZERO_BYTES = 1 * MiB;
constexpr int CW_TMO = 0, CW_CODE = 1, CW_WPC = 2, CW_BAR = 4096;
constexpr size_t CTL_CMAXQ = 912 * 1024;
constexpr size_t CTL_DMAX = 384 * 1024, CTL_WPMAX = 448 * 1024;
constexpr size_t CTL_CMAXU = 896 * 1024;
constexpr size_t CTL_CMAX = 640 * 1024, CTL_RMAX = 768 * 1024;
constexpr size_t CTL_SS2 = 256 * 1024, CTL_SS3 = 512 * 1024;
constexpr size_t WS_R1 = 1 * MiB;
constexpr size_t WS_COSA = 2 * MiB, WS_SINA = 2 * MiB + 512 * 1024, WS_COSI = 3 * MiB, WS_SINI = 3 * MiB + 256 * 1024;
constexpr size_t WS_IW = 4 * MiB, WS_IK = 5 * MiB, WS_TOPK = 8 * MiB;
constexpr size_t WS_WIN = 16 * MiB, WS_WOUT = 66 * MiB, WS_WGU = 98 * MiB, WS_WDN = 270 * MiB, WS_WPOOL = 356 * MiB;
constexpr size_t WS_XH = 360 * MiB, WS_Q = 488 * MiB, WS_K = 552 * MiB, WS_V = 568 * MiB, WS_IQ = 584 * MiB, WS_U = 616 * MiB, WS_PD = 680 * MiB, WS_MIX = 744 * MiB;
constexpr size_t WS_X8 = 744 * MiB, WS_W8 = 808 * MiB;
constexpr size_t WS_A = 488 * MiB;
constexpr size_t WS_XA = 872 * MiB;
constexpr size_t WS_DIFFB = 872 * MiB, WS_WPB = 936 * MiB;
constexpr size_t WS_XMAX = 1 * MiB + 128 * 1024;
constexpr size_t WS_R1X = 1 * MiB + 256 * 1024;
constexpr size_t WS_X8I = 872 * MiB, WS_W8I = 936 * MiB;
constexpr size_t WS_WORAW = 680 * MiB;
constexpr size_t WS_END = FFN_F8K ? 984 * MiB : 872 * MiB;
constexpr int KF6 = FFN_F8K ? 1792 : 0, XAB = KF6 + 2 * (DM - KF6);
constexpr int KF7 = FFN_F8K ? DFF : 0, ABB = KF7 + 2 * (DFF - KF7);
static_assert(KF6 % 256 == 0 && KF7 % 256 == 0, "fp8 K parts: whole K-tile pairs, whole epilogue column tiles");
constexpr int MIXB = OUT_I8P ? 4096 : OUT_FP8 ? 2048 + 2 * 2048 : 2 * DM;
constexpr int MIX_POOL0 = OUT_FP8 ? 1024 : 2048;
static_assert(WS_WIN + (size_t)NIN_T * DM * 2 <= WS_WOUT && WS_WGU + (size_t)NGU * DM * 2 <= WS_WDN && WS_WDN + (size_t)DM * DFF * 2 <= WS_WPOOL && WS_A + (size_t)M * DFF * 2 <= WS_END, "ws map");

constexpr int SCRATCH_BYTES = 151552;
constexpr int LDSCTL_OFF = SCRATCH_BYTES;
constexpr int LDS_BYTES = 155648;

#define RLX_AGENT __ATOMIC_RELAXED, __HIP_MEMORY_SCOPE_AGENT
#define LDS_WAIT() asm volatile("s_waitcnt lgkmcnt(0)" ::: "memory")
#define VM_WAIT() asm volatile("s_waitcnt vmcnt(0)" ::: "memory")

#define XB_TMO      128
#define XB_XCNT(j)  (256  + 64 * (j))
#define XB_XSUB(j)  (1280 + 64 * (j))
#define XB_XGEN(j)  (2304 + 64 * (j))
#define XB_TOP      3328
#define XB_TOPGEN   3392
#define XCD_BAR_WORDS 3456
#define XB_SPIN_CAP (1u << 18)

__device__ __forceinline__ unsigned xb_ld(unsigned* p)              { return __hip_atomic_load(p, __ATOMIC_RELAXED, __HIP_MEMORY_SCOPE_AGENT); }
__device__ __forceinline__ unsigned xb_add(unsigned* p, unsigned v) { return __hip_atomic_fetch_add(p, v, __ATOMIC_RELAXED, __HIP_MEMORY_SCOPE_AGENT); }
__device__ __forceinline__ unsigned xb_xcc_id() { return (unsigned)__builtin_amdgcn_s_getreg((3 << 11) | 20) & 0xFu; }
#define XB_SPIN(cond, bar) do { unsigned _sp = 0; while (cond) { __builtin_amdgcn_s_sleep(1); \
    if ((++_sp & 255u) == 0u) { if (xb_ld(&(bar)[XB_TMO])) break; if (_sp > XB_SPIN_CAP) { atomicAdd(&(bar)[XB_TMO], 1u); break; } } } } while (0)

__device__ __forceinline__ int fresh_tid(int wave) { int l; asm volatile("v_mbcnt_lo_u32_b32 %0, -1, 0\n\tv_mbcnt_hi_u32_b32 %0, -1, %0" : "=v"(l)); return wave * 64 + l; }

struct XcdBarrier { unsigned* bar; unsigned x; volatile LAS unsigned* st; int wave; };

__device__ __forceinline__ XcdBarrier xcd_barrier_post(unsigned* bar, volatile LAS unsigned* st, int wave) {
    XcdBarrier b; b.bar = bar; b.x = xb_xcc_id(); b.st = st; b.wave = wave;
    if (fresh_tid(wave) == 0) (void)xb_add(&bar[XB_XCNT(b.x)], 1u);
    return b;
}
__device__ __forceinline__ void xcd_barrier_complete(unsigned* bar, unsigned x, unsigned& nloc, unsigned& nx) {
    const unsigned G = gridDim.x * gridDim.y * gridDim.z;
    unsigned sum, cnt, mine, sp = 0u;
    for (;;) {
        sum = 0u; cnt = 0u; mine = 0u;
#pragma unroll
        for (unsigned j = 0; j < 16; ++j) { const unsigned c = xb_ld(&bar[XB_XCNT(j)]); sum += c; cnt += (c > 0u) ? 1u : 0u; mine = (j == x) ? c : mine; }
        if (sum == G) break;
        __builtin_amdgcn_s_sleep(1);
        if ((++sp & 255u) == 0u) { if (xb_ld(&bar[XB_TMO])) break; if (sp > XB_SPIN_CAP) { atomicAdd(&bar[XB_TMO], 1u); break; } }
    }
    nloc = mine > 0u ? mine : 1u; nx = cnt > 0u ? cnt : 1u;
}
__device__ __forceinline__ void xcd_barrier(const XcdBarrier& b) {
    asm volatile("s_waitcnt vmcnt(0)" ::: "memory");
    __syncthreads();
    if (fresh_tid(b.wave) == 0) {
        unsigned* bar = b.bar;
        __builtin_amdgcn_s_waitcnt(0);
        unsigned nloc = b.st[0], nx = b.st[1];
        if (nloc == 0u) { xcd_barrier_complete(bar, b.x, nloc, nx); b.st[0] = nloc; b.st[1] = nx; }
        const unsigned old = xb_add(&bar[XB_XSUB(b.x)], 1u);
        const unsigned gen = old / nloc;
        if (old + 1u == (gen + 1u) * nloc) {
            __builtin_amdgcn_fence(__ATOMIC_RELEASE, "agent");
            asm volatile("s_waitcnt vmcnt(0)" ::: "memory");
            const unsigned og = xb_add(&bar[XB_TOP], 1u);
            const unsigned tg = og / nx;
            if (og + 1u == (tg + 1u) * nx) xb_add(&bar[XB_TOPGEN], 1u);
            else XB_SPIN(xb_ld(&bar[XB_TOPGEN]) == tg, bar);
            __builtin_amdgcn_fence(__ATOMIC_ACQUIRE, "agent");
            xb_add(&bar[XB_XGEN(b.x)], 1u);
            asm volatile("s_waitcnt vmcnt(0)" ::: "memory");
        } else {
            XB_SPIN(xb_ld(&bar[XB_XGEN(b.x)]) == gen, bar);
            __builtin_amdgcn_fence(__ATOMIC_ACQUIRE, "agent");
            asm volatile("s_waitcnt vmcnt(0)" ::: "memory");
        }
    }
    __syncthreads();
}

namespace pg8 {
constexpr int BM = 256, BK = 64, HALF = 128, HTB = HALF * BK * 2, STAGE_BYTES = 8 * HTB, NXCD = 8, WGM = 8;
__host__ __device__ __forceinline__ int lds_byte(int r, int c) { const int st = (r >> 4) * 2 + (c >> 5), rr = r & 15, cc = c & 31, ob = rr * 64 + cc * 2; return st * 1024 + (ob ^ (((ob >> 9) & 1) << 5)); }
__host__ __device__ __forceinline__ void stage_rc(int b, int& R, int& C) { const int st = b / 1024, sb = b % 1024, swz = sb ^ (((sb >> 9) & 1) << 5); R = (st >> 1) * 16 + swz / 64; C = (st & 1) * 32 + (swz % 64) / 2; }
__host__ __device__ __forceinline__ int perm32(int rho) { const int n = rho >> 4, i = rho & 15; return 8 * (i >> 2) + 4 * n + (i & 3); }

constexpr int F8_ALL = 1 << 20;
struct Unit { int pm, pn, half; };
struct Gemm { const char* A; const char* Bt; int lda, ldb, K; int pool; unsigned sc8 = 0x7f7f7f7fu; const float* cs8 = nullptr; const float* rs8 = nullptr; };
__device__ __forceinline__ const char* a_tile(const Gemm& g, const Unit& u) { return g.A + ((size_t)u.pm * 256 + (u.half > 0 ? 128 : 0)) * g.lda * 2 + (g.pool ? (size_t)(u.pn >> 1) * 512 * 2 : 0); }
__device__ __forceinline__ const char* b_tile(const Gemm& g, const Unit& u) { return g.Bt + (size_t)u.pn * 256 * g.ldb * 2; }

struct StaticOrder {
    int nM, nN, nwg, G, c, tail, imax, hbase;
    __host__ __device__ void init(int nM_, int nN_, int G_, int c_, int tail_ = 0) { nM = nM_; nN = nN_; nwg = nM * nN; G = G_; c = c_; tail = tail_; imax = 1 << 30; hbase = -1; }
    __host__ __device__ bool next(int i, Unit& u) const {
        u.half = -1;
        if (tail) { const int L = i * G + c; if (L >= nM) return false; u.pm = L; u.pn = tail; return true; }
        if (i >= imax) return false;
        long L = (long)i * G + c;
        if (hbase >= 0) { if (i > 0) return false; L = (long)hbase + (c >> 1); u.half = c & 1; }
        if (L >= nwg) return false;
        int wgid = (int)L; { const int q = nwg / NXCD, r = nwg % NXCD, xcd = wgid % NXCD, off = wgid / NXCD; wgid = (xcd < r ? xcd * (q + 1) : r * (q + 1) + (xcd - r) * q) + off; }
        const int nig = WGM * nN, gid = wgid / nig, fm = gid * WGM, gsz = (nM - fm) < WGM ? (nM - fm) : WGM;
        u.pm = fm + ((wgid % nig) % gsz); u.pn = (wgid % nig) / gsz; return true;
    }
};

template <class Epi, bool BF = false, bool ALIGN_EPI = true, bool HM = false, bool HN = false, int F8T = 0, bool I8 = false, int I8T = 0>
__device__ __forceinline__ void gemm_phase(LAS unsigned char* lds, const Gemm g, const StaticOrder& S, const Epi& E, const int wid) {
    const int tid = fresh_tid(wid);
    const int lane = tid & 63, wr = wid >> 2, wc = wid & 3, fr = lane & 15, fq = lane >> 4;
    const int K = g.K, nt = K / BK;
    unsigned voffA[2], voffB[2];
#pragma unroll
    for (int i = 0; i < 2; ++i) { int R, C; stage_rc(tid * 16 + i * 8192, R, C); const int Rb = (R & ~31) + perm32(R & 31);
        voffA[i] = (unsigned)(R * g.lda + C) * 2u; voffB[i] = (unsigned)(Rb * g.ldb + C) * 2u; }
    const size_t kstep = (size_t)(BK * 2);
    const size_t hstepA = (size_t)HALF * g.lda * 2, hstepB = (size_t)HALF * g.ldb * 2;
    const unsigned ldsw = (unsigned)wid * 1024u;
    const int aoff = lds_byte(wr * 64 + fr, fq * 8), boff = lds_byte(wc * 32 + fr, fq * 8);
#define PG8_SA(b, h) (((b) * 2 + (h)) * HTB)
#define PG8_SB(b, h) ((4 + (b) * 2 + (h)) * HTB)
#define PG8_STAGE(bufoff, gbase, voff) do { _Pragma("unroll") for (int _i = 0; _i < 2; ++_i) { unsigned _vo = (voff)[_i]; asm volatile("" : "+v"(_vo));   \
        __builtin_amdgcn_global_load_lds((const unsigned*)((const char*)(gbase) + _vo), (LAS unsigned*)(lds + (bufoff) + ldsw + _i * 8192), 16, 0, 0); } } while (0)
#define PG8_CAT8(lo, hi) __builtin_bit_cast(i32x8, __builtin_shufflevector(lo, hi, 0, 1, 2, 3, 4, 5, 6, 7))
#define PG8_LDA(dst, b, h) do { if constexpr (F8) { _Pragma("unroll") for (int m = 0; m < 4; ++m) dst##8[m] = PG8_CAT8(*(const LAS u32x4*)(lds + PG8_SA(b, h) + aoff + m * 2048), *(const LAS u32x4*)(lds + PG8_SA(b, h) + aoff + m * 2048 + 1024)); } \
        else { _Pragma("unroll") for (int m = 0; m < 4; ++m) _Pragma("unroll") for (int k = 0; k < 2; ++k) dst[m][k] = *(const LAS f16x8*)(lds + PG8_SA(b, h) + aoff + m * 2048 + k * 1024); } } while (0)
#define PG8_LDB(dst, b, h) do { if constexpr (F8) { _Pragma("unroll") for (int n = 0; n < 2; ++n) dst##8[n] = PG8_CAT8(*(const LAS u32x4*)(lds + PG8_SB(b, h) + boff + n * 2048), *(const LAS u32x4*)(lds + PG8_SB(b, h) + boff + n * 2048 + 1024)); } \
        else { _Pragma("unroll") for (int n = 0; n < 2; ++n) _Pragma("unroll") for (int k = 0; k < 2; ++k) dst[n][k] = *(const LAS f16x8*)(lds + PG8_SB(b, h) + boff + n * 2048 + k * 1024); } } while (0)
#define PG8_MMA(ai, bj, At, Bt) do { if constexpr (F8) { __builtin_amdgcn_s_setprio(1); _Pragma("unroll") for (int m = 0; m < 4; ++m) _Pragma("unroll") for (int n = 0; n < 2; ++n) \
        acc[ai][bj][m][n] = __builtin_amdgcn_mfma_scale_f32_16x16x128_f8f6f4(Bt##8[n], At##8[m], acc[ai][bj][m][n], 0, 0, 0, (int)g.sc8, 0, (int)g.sc8); \
        __builtin_amdgcn_s_setprio(0); } else { __builtin_amdgcn_s_setprio(1); _Pragma("unroll") for (int m = 0; m < 4; ++m) _Pragma("unroll") for (int n = 0; n < 2; ++n) _Pragma("unroll") for (int k = 0; k < 2; ++k) \
        { if constexpr (I8L) acc[ai][bj][m][n] = __builtin_bit_cast(f32x4, __builtin_amdgcn_mfma_i32_16x16x64_i8(__builtin_bit_cast(i32x4, Bt[n][k]), __builtin_bit_cast(i32x4, At[m][k]), __builtin_bit_cast(i32x4, acc[ai][bj][m][n]), 0, 0, 0)); \
          else if constexpr (BF) acc[ai][bj][m][n] = __builtin_amdgcn_mfma_f32_16x16x32_bf16(__builtin_bit_cast(bf16x8, Bt[n][k]), __builtin_bit_cast(bf16x8, At[m][k]), acc[ai][bj][m][n], 0, 0, 0); \
          else acc[ai][bj][m][n] = __builtin_amdgcn_mfma_f32_16x16x32_f16(Bt[n][k], At[m][k], acc[ai][bj][m][n], 0, 0, 0); } __builtin_amdgcn_s_setprio(0); } } while (0)
#define PG8_WAIT_V(n) asm volatile("s_waitcnt vmcnt(" #n ")" ::: "memory")
#define PG8_WAIT_L(n) asm volatile("s_waitcnt lgkmcnt(" #n ")" ::: "memory")
#define PG8_BAR __builtin_amdgcn_s_barrier()
#define PG8_SCHED __builtin_amdgcn_sched_barrier(0)
#define PG8_KBODY \
            const bool last = (t == nt - 2); \
            const char* a1 = cA + (size_t)(t + 1) * kstep; \
            const char* a2 = last ? nA : cA + (size_t)(t + 2) * kstep; const char* b2 = last ? nB : cB + (size_t)(t + 2) * kstep; \
            const char* a3 = a2 + kstep; const char* b3 = b2 + kstep; \
            PG8_LDB(B0, 0, 0); if constexpr (!HN) PG8_LDB(B1, 0, 1); PG8_SCHED; PG8_LDA(At, 0, 0); PG8_STAGE(PG8_SA(1, 1), a1 + hstepA, voffA); \
            PG8_WAIT_V(8); PG8_WAIT_L(0); PG8_BAR; PG8_MMA(0, 0, At, B0); if constexpr (!HN) PG8_MMA(0, 1, At, B1); PG8_BAR; PG8_SCHED; \
            if constexpr (!HM) PG8_LDA(At, 0, 1); PG8_STAGE(PG8_SB(0, 0), b2, voffB); PG8_STAGE(PG8_SB(0, 1), b2 + hstepB, voffB); PG8_STAGE(PG8_SA(0, 0), a2, voffA); \
            PG8_WAIT_V(8); PG8_WAIT_L(0); PG8_BAR; if constexpr (!HM) { PG8_MMA(1, 0, At, B0); if constexpr (!HN) PG8_MMA(1, 1, At, B1); } PG8_BAR; PG8_SCHED; \
            PG8_LDB(B0, 1, 0); if constexpr (!HN) PG8_LDB(B1, 1, 1); PG8_SCHED; PG8_LDA(At, 1, 0); PG8_STAGE(PG8_SA(0, 1), a2 + hstepA, voffA); \
            PG8_WAIT_V(8); PG8_WAIT_L(0); PG8_BAR; PG8_MMA(0, 0, At, B0); if constexpr (!HN) PG8_MMA(0, 1, At, B1); PG8_BAR; PG8_SCHED; \
            if constexpr (!HM) PG8_LDA(At, 1, 1); PG8_STAGE(PG8_SB(1, 0), b3, voffB); PG8_STAGE(PG8_SB(1, 1), b3 + hstepB, voffB); PG8_STAGE(PG8_SA(1, 0), a3, voffA); \
            PG8_WAIT_V(8); PG8_WAIT_L(0); PG8_BAR; if constexpr (!HM) { PG8_MMA(1, 0, At, B0); if constexpr (!HN) PG8_MMA(1, 1, At, B1); } PG8_BAR; PG8_SCHED;
    Unit cur, nxt; int ui = 0;
    if (!S.next(0, cur)) return;
    f32x4 acc[2][2][4][2];
#pragma unroll
    for (int a = 0; a < 2; ++a)
#pragma unroll
        for (int b = 0; b < 2; ++b)
#pragma unroll
            for (int m = 0; m < 4; ++m)
#pragma unroll
                for (int n = 0; n < 2; ++n) acc[a][b][m][n] = (f32x4){0.f, 0.f, 0.f, 0.f};
    f16x8 At[4][2], B0[2][2], B1[2][2]; i32x8 At8[4], B08[2], B18[2];
    const char* cA = a_tile(g, cur); const char* cB = b_tile(g, cur);
    PG8_STAGE(PG8_SB(0, 0), cB, voffB); PG8_STAGE(PG8_SB(0, 1), cB + hstepB, voffB); PG8_STAGE(PG8_SA(0, 0), cA, voffA); PG8_STAGE(PG8_SA(0, 1), cA + hstepA, voffA);
    if (wr == 1) PG8_BAR;
    PG8_WAIT_V(2); PG8_BAR;
    PG8_STAGE(PG8_SB(1, 0), cB + kstep, voffB); PG8_STAGE(PG8_SA(1, 0), cA + kstep, voffA); PG8_STAGE(PG8_SB(1, 1), cB + hstepB + kstep, voffB);
    PG8_WAIT_V(6); PG8_BAR;
    for (;;) {
        const bool has_next = S.next(ui + 1, nxt);
        const char* nA = has_next ? a_tile(g, nxt) : cA; const char* nB = has_next ? b_tile(g, nxt) : cB;
        int t = 0;
        if constexpr (I8T > 0) {
            { constexpr bool F8 = false; constexpr bool I8L = true;
              _Pragma("nounroll") for (; t < I8T; t += 2) { PG8_KBODY } }
            const int te = fresh_tid(wid), fre = te & 15, fqe = (te >> 4) & 3;
            float rsc[2][4];
#pragma unroll
            for (int ai = 0; ai < 2; ++ai)
#pragma unroll
                for (int m = 0; m < 4; ++m) rsc[ai][m] = g.rs8[cur.pm * 256 + ai * 128 + wr * 64 + m * 16 + fre] * (1.0f / (127.0f * 127.0f));
#pragma unroll
            for (int bj = 0; bj < 2; ++bj) { const f32x4* cp = (const f32x4*)(g.cs8 + cur.pn * 256 + bj * 128 + wc * 32 + 8 * fqe); const f32x4 c0 = cp[0], c1 = cp[1];
#pragma unroll
                for (int ai = 0; ai < 2; ++ai)
#pragma unroll
                    for (int m = 0; m < 4; ++m) { const i32x4 i0 = __builtin_bit_cast(i32x4, acc[ai][bj][m][0]), i1 = __builtin_bit_cast(i32x4, acc[ai][bj][m][1]);
                        acc[ai][bj][m][0] = (f32x4){(float)i0[0], (float)i0[1], (float)i0[2], (float)i0[3]} * c0 * rsc[ai][m]; acc[ai][bj][m][1] = (f32x4){(float)i1[0], (float)i1[1], (float)i1[2], (float)i1[3]} * c1 * rsc[ai][m]; } }
        }
        if constexpr (F8T > 0) { constexpr bool F8 = true; constexpr bool I8L = false; const int te8 = F8T < F8_ALL ? F8T : nt;
            _Pragma("nounroll") for (; t < te8; t += 2) { PG8_KBODY } }
        if constexpr (F8T < F8_ALL) { constexpr bool F8 = false; constexpr bool I8L = I8;
            _Pragma("nounroll") for (; t < nt; t += 2) { PG8_KBODY } }
        if constexpr (ALIGN_EPI) { if (wr == 0) PG8_BAR; }
        if constexpr (I8) { if (g.cs8) {
            const int te = fresh_tid(wid), fqe = (te >> 4) & 3;
#pragma unroll
            for (int bj = 0; bj < 2; ++bj) { const f32x4* cp = (const f32x4*)(g.cs8 + cur.pn * 256 + bj * 128 + wc * 32 + 8 * fqe); const f32x4 c0 = cp[0] * (1.0f / 127.0f), c1 = cp[1] * (1.0f / 127.0f);
#pragma unroll
                for (int ai = 0; ai < 2; ++ai)
#pragma unroll
                    for (int m = 0; m < 4; ++m) { const i32x4 i0 = __builtin_bit_cast(i32x4, acc[ai][bj][m][0]), i1 = __builtin_bit_cast(i32x4, acc[ai][bj][m][1]);
                        acc[ai][bj][m][0] = (f32x4){(float)i0[0], (float)i0[1], (float)i0[2], (float)i0[3]} * c0; acc[ai][bj][m][1] = (f32x4){(float)i1[0], (float)i1[1], (float)i1[2], (float)i1[3]} * c1; } }
        } }
        if constexpr (F8T != 0 || I8 || I8T != 0) { const int te = fresh_tid(wid); E(acc, cur, wr, wc, te & 15, (te >> 4) & 3); }
        else E(acc, cur, wr, wc, fr, fq);
        if (!has_next) break;
#pragma unroll
        for (int a = 0; a < 2; ++a)
#pragma unroll
            for (int b = 0; b < 2; ++b)
#pragma unroll
                for (int m = 0; m < 4; ++m)
#pragma unroll
                    for (int n = 0; n < 2; ++n) acc[a][b][m][n] = (f32x4){0.f, 0.f, 0.f, 0.f};
        cur = nxt; cA = nA; cB = nB; ++ui;
        if constexpr (ALIGN_EPI) { if (wr == 1) PG8_BAR; }
    }
    PG8_WAIT_V(0);
    if constexpr (!ALIGN_EPI) { if (wr == 0) PG8_BAR; }
    PG8_BAR;
#undef PG8_KBODY
#undef PG8_SA
#undef PG8_SB
#undef PG8_STAGE
#undef PG8_LDA
#undef PG8_LDB
#undef PG8_CAT8
#undef PG8_MMA
#undef PG8_WAIT_V
#undef PG8_WAIT_L
#undef PG8_BAR
#undef PG8_SCHED
}
}

__device__ __forceinline__ unsigned pkh(float lo, float hi) { f16x2 v; v.x = (f16)lo; v.y = (f16)hi; return __builtin_bit_cast(unsigned, v); }
__device__ __forceinline__ unsigned pkb(float lo, float hi) { unsigned r; asm volatile("v_cvt_pk_bf16_f32 %0, %1, %2" : "=v"(r) : "v"(lo), "v"(hi)); return r; }
template <bool BF> __device__ __forceinline__ unsigned pk2t(float lo, float hi) { if constexpr (BF) return pkb(lo, hi); else return pkh(lo, hi); }
template <bool BF> __device__ __forceinline__ u32x4 pk8t(f32x4 a, f32x4 b) { u32x4 w; w.x = pk2t<BF>(a[0], a[1]); w.y = pk2t<BF>(a[2], a[3]); w.z = pk2t<BF>(b[0], b[1]); w.w = pk2t<BF>(b[2], b[3]); return w; }
__device__ __forceinline__ u32x4 pk8(f32x4 a, f32x4 b) { u32x4 w; w.x = pkh(a[0], a[1]); w.y = pkh(a[2], a[3]); w.z = pkh(b[0], b[1]); w.w = pkh(b[2], b[3]); return w; }
__device__ __forceinline__ float wave_sum(float v) {
#pragma unroll
    for (int o = 1; o < 64; o <<= 1) v += __shfl_xor(v, o);
    return v;
}
__device__ __forceinline__ f32x4 shx4(f32x4 v, int m) { f32x4 r; r[0] = __shfl_xor(v[0], m); r[1] = __shfl_xor(v[1], m); r[2] = __shfl_xor(v[2], m); r[3] = __shfl_xor(v[3], m); return r; }

__device__ __forceinline__ void sincos_d(double x, double& s, double& c) {
    const double k = rint(x * 0.63661977236758134308);
    double r = fma(-k, 1.57079632679489655800e+00, x); r = fma(-k, 6.12323399573676603587e-17, r);
    const double r2 = r * r;
    double ps = -1.0 / 1307674368000.0; ps = fma(ps, r2, 1.0 / 6227020800.0); ps = fma(ps, r2, -1.0 / 39916800.0); ps = fma(ps, r2, 1.0 / 362880.0); ps = fma(ps, r2, -1.0 / 5040.0);
    ps = fma(ps, r2, 1.0 / 120.0); ps = fma(ps, r2, -1.0 / 6.0); ps = fma(ps, r2, 1.0); ps *= r;
    double pc = 1.0 / 20922789888000.0; pc = fma(pc, r2, -1.0 / 87178291200.0); pc = fma(pc, r2, 1.0 / 479001600.0); pc = fma(pc, r2, -1.0 / 3628800.0); pc = fma(pc, r2, 1.0 / 40320.0);
    pc = fma(pc, r2, -1.0 / 720.0); pc = fma(pc, r2, 1.0 / 24.0); pc = fma(pc, r2, -0.5); pc = fma(pc, r2, 1.0);
    const int q = ((int)k) & 3;
    s = (q == 0) ? ps : (q == 1) ? pc : (q == 2) ? -ps : -pc;
    c = (q == 0) ? pc : (q == 1) ? -ps : (q == 2) ? -pc : ps;
}

using pg8::Unit;
__device__ __forceinline__ void rope8(f32x4& v0, f32x4& v1, const f32x4 (&cs)[2], const f32x4 (&sn)[2], int xmask, float sgn, bool act) {
    const f32x4 p0 = shx4(v0, xmask), p1 = shx4(v1, xmask);
    if (act) { v0 = v0 * cs[0] + (p0 * sn[0]) * sgn; v1 = v1 * cs[1] + (p1 * sn[1]) * sgn; }
}
__device__ __forceinline__ f32x2 swap32_pair(float x) { const unsigned u = __builtin_bit_cast(unsigned, x); auto t = __builtin_amdgcn_permlane32_swap(u, u, false, false); return __builtin_bit_cast(f32x2, t); }
__device__ __forceinline__ f32x2 swap16_pair(float x) { const unsigned u = __builtin_bit_cast(unsigned, x); auto t = __builtin_amdgcn_permlane16_swap(u, u, false, false); return __builtin_bit_cast(f32x2, t); }
__device__ __forceinline__ float sum_x16_x32(float x) { f32x2 p = swap16_pair(x); x = p[0] + p[1]; p = swap32_pair(x); return p[0] + p[1]; }
__device__ __forceinline__ float max_x16_x32(float x) { f32x2 p = swap16_pair(x); x = fmaxf(p[0], p[1]); p = swap32_pair(x); return fmaxf(p[0], p[1]); }
template <int SEL = 0> struct EpiInT {
    const float* r1; const float *cosA, *sinA, *cosI, *sinI; f16 *Q, *Kb, *Vb, *IQ, *IK, *U; float* IW; int pn_off; float rmul;
    __device__ __forceinline__ void operator()(const f32x4 (&acc)[2][2][4][2], const Unit& u, int wr, int wc, int fr, int fq) const {
        const int pn = u.pn + pn_off;
        const bool ropeA = SEL != 2 && pn < 10 && wc == 0;
        const bool ropeI = SEL != 1 && ((pn >= 12 && pn < 16 && (wc & 1) == 0) || (pn >= 24 && wc == 0));
#pragma unroll
        for (int ab = 0; ab < 4; ++ab) { const int ai = ab >> 1, m0 = (ab & 1) * 2;
            float rs[4]; f32x4 cs[4][2], sn[4][2];
#pragma unroll
            for (int m = m0; m < m0 + 2; ++m) {
                const int row = u.pm * 256 + ai * 128 + wr * 64 + m * 16 + fr, t = row & (SEQ - 1); rs[m] = r1[row] * rmul;
                const float* cp = ropeA ? cosA + t * 16 + 8 * (fq & 1) : cosI + t * 8; const float* sp = ropeA ? sinA + t * 16 + 8 * (fq & 1) : sinI + t * 8;
                if (ropeA || ropeI) { cs[m][0] = *(const f32x4*)cp; cs[m][1] = *(const f32x4*)(cp + 4); sn[m][0] = *(const f32x4*)sp; sn[m][1] = *(const f32x4*)(sp + 4); }
                else { cs[m][0] = cs[m][1] = (f32x4){1.f, 1.f, 1.f, 1.f}; sn[m][0] = sn[m][1] = (f32x4){0.f, 0.f, 0.f, 0.f}; }
            }
            asm volatile("" ::: "memory");
#pragma unroll
            for (int m = m0; m < m0 + 2; ++m) {
                const int row = u.pm * 256 + ai * 128 + wr * 64 + m * 16 + fr;
#pragma unroll
                for (int bj = 0; bj < 2; ++bj) {
                    f32x4 v0 = acc[ai][bj][m][0] * rs[m], v1 = acc[ai][bj][m][1] * rs[m];
                    const int lc = bj * 128 + wc * 32 + 8 * fq;
                    if (SEL == 1 || (SEL == 0 && pn < 12)) {
                        if (ropeA) rope8(v0, v1, cs[m], sn[m], 32, fq < 2 ? -1.f : 1.f, true);
                        if ((K_FP8 && pn >= 8 && pn < 10) || (V_FP8 && pn >= 10)) {
                            int w0 = __builtin_amdgcn_cvt_pk_fp8_f32(v0[0], v0[1], 0, false); w0 = __builtin_amdgcn_cvt_pk_fp8_f32(v0[2], v0[3], w0, true);
                            int w1 = __builtin_amdgcn_cvt_pk_fp8_f32(v1[0], v1[1], 0, false); w1 = __builtin_amdgcn_cvt_pk_fp8_f32(v1[2], v1[3], w1, true);
                            u32x2 w; w.x = (unsigned)w0; w.y = (unsigned)w1; *(u32x2*)((pn < 10 ? (unsigned char*)Kb + (size_t)row * NKV + (pn - 8) * 256 : (unsigned char*)Vb + (size_t)row * NKV + (pn - 10) * 256) + lc) = w;
                        } else {
                        f16* dst = pn < 8 ? Q + (size_t)row * NQ + pn * 256 + lc : pn < 10 ? Kb + (size_t)row * NKV + (pn - 8) * 256 + lc : Vb + (size_t)row * NKV + (pn - 10) * 256 + lc;
                        *(u32x4*)dst = pk8(v0, v1); }
                    } else if (pn < 16) {
                        if (ropeI) rope8(v0, v1, cs[m], sn[m], 16, fq == 0 ? -1.f : 1.f, fq < 2);
                        *(u32x4*)(IQ + (size_t)row * NIQ + (pn - 12) * 256 + lc) = pk8(v0, v1);
                    } else if (pn < 24) {
                        *(u32x4*)(U + (size_t)row * NU + (pn - 16) * 256 + lc) = pk8(v0, v1);
                    } else {
                        if (bj == 0) {
                            if (ropeI) rope8(v0, v1, cs[m], sn[m], 16, fq == 0 ? -1.f : 1.f, fq < 2);
                            if (wc < 2) *(u32x4*)(IK + (size_t)row * NIK + wc * 32 + 8 * fq) = pk8(v0, v1);
                            else if (wc == 2 && fq < 2) { *(f32x4*)(IW + (size_t)row * NIW + 8 * fq) = v0; *(f32x4*)(IW + (size_t)row * NIW + 8 * fq + 4) = v1; }
                        }
                    }
                }
            }
        }
    }
};
typedef EpiInT<0> EpiIn;
struct EpiU8 {
    const float* r1; const float* xmax; const float* cmaxu; f16* U;
    __device__ __forceinline__ void operator()(const f32x4 (&acc)[2][2][4][2], const Unit& u, int wr, int wc, int fr, int fq) const {
        f32x4 cs[2][2];
#pragma unroll
        for (int bj = 0; bj < 2; ++bj) { const f32x4* cp = (const f32x4*)(cmaxu + u.pn * 256 + bj * 128 + wc * 32 + 8 * fq); cs[bj][0] = cp[0] * (1.0f / 127.0f); cs[bj][1] = cp[1] * (1.0f / 127.0f); }
#pragma unroll
        for (int ai = 0; ai < 2; ++ai) {
            float rs[4];
#pragma unroll
            for (int m = 0; m < 4; ++m) { const int row = u.pm * 256 + ai * 128 + wr * 64 + m * 16 + fr; rs[m] = r1[row] * xmax[row] * (1.0f / 127.0f); }
#pragma unroll
            for (int m = 0; m < 4; ++m) { const int row = u.pm * 256 + ai * 128 + wr * 64 + m * 16 + fr;
#pragma unroll
                for (int bj = 0; bj < 2; ++bj) { const i32x4 i0 = __builtin_bit_cast(i32x4, acc[ai][bj][m][0]), i1 = __builtin_bit_cast(i32x4, acc[ai][bj][m][1]);
                    const f32x4 v0 = (f32x4){(float)i0[0], (float)i0[1], (float)i0[2], (float)i0[3]} * cs[bj][0] * rs[m], v1 = (f32x4){(float)i1[0], (float)i1[1], (float)i1[2], (float)i1[3]} * cs[bj][1] * rs[m];
                    *(u32x4*)(U + (size_t)row * NU + u.pn * 256 + bj * 128 + wc * 32 + 8 * fq) = pk8(v0, v1); } }
        }
    }
};
struct EpiPool {
    const float* pscale; f16* MIX; float* wpmax;
    __device__ __forceinline__ void operator()(const f32x4 (&acc)[2][2][4][2], const Unit& u, int wr, int wc, int fr, int fq) const {
#pragma unroll
        for (int bj = 0; bj < 2; ++bj) {
            const int c0 = u.pn * 256 + bj * 128 + wc * 32 + 8 * fq;
            f32x4 s0 = {1.f, 1.f, 1.f, 1.f}, s1 = s0; if (pscale) { s0 = *(const f32x4*)(pscale + c0); s1 = *(const f32x4*)(pscale + c0 + 4); }
#pragma unroll
            for (int ai = 0; ai < 2; ++ai)
#pragma unroll
                for (int m = 0; m < 4; ++m) { const int row = u.pm * 256 + ai * 128 + wr * 64 + m * 16 + fr;
                    const f32x4 w0 = acc[ai][bj][m][0] * s0, w1 = acc[ai][bj][m][1] * s1;
                    if (OUT_I8P && wpmax) { *(u32x4*)(MIX + (size_t)row * 2048 + c0) = pk8t<FFN_BF16 != 0>(w0, w1);
                        float mx = fmaxf(fmaxf(fmaxf(fabsf(w0[0]), fabsf(w0[1])), fmaxf(fabsf(w0[2]), fabsf(w0[3]))), fmaxf(fmaxf(fabsf(w1[0]), fabsf(w1[1])), fmaxf(fabsf(w1[2]), fabsf(w1[3]))));
                        mx = fmaxf(mx, __shfl_xor(mx, 16)); mx = fmaxf(mx, __shfl_xor(mx, 32));
                        if (fq == 0) atomicMax((unsigned*)wpmax + row, __builtin_bit_cast(unsigned, mx)); }
                    else *(u32x4*)(MIX + (size_t)row * (MIXB / 2) + MIX_POOL0 + c0) = pk8t<FFN_BF16 != 0>(w0, w1); }
        }
    }
};
template <bool IN_BF, bool OUT_BF, int XA = 0> struct EpiRes {
    f16* xh; float* ss; unsigned char* xa;
    __device__ __forceinline__ void operator()(const f32x4 (&acc)[2][2][4][2], const Unit& u, int wr, int wc, int fr, int fq) const {
        const int col0 = u.pn * 256 + wc * 32 + 8 * fq;
#pragma unroll
        for (int ai = 0; ai < 2; ++ai) {
            u32x4 xin[4][2];
#pragma unroll
            for (int m = 0; m < 4; ++m)
#pragma unroll
                for (int bj = 0; bj < 2; ++bj) { const size_t r = (size_t)(u.pm * 256 + ai * 128 + wr * 64 + m * 16 + fr);
                    if (XA == 2 && u.pn * 256 >= KF6) xin[m][bj] = *(const u32x4*)(xa + r * XAB + KF6 + (size_t)(col0 + bj * 128 - KF6) * 2);
                    else xin[m][bj] = *(const u32x4*)(xh + r * DM + col0 + bj * 128); }
            asm volatile("" ::: "memory");
#pragma unroll
            for (int m = 0; m < 4; ++m) {
                const int row = u.pm * 256 + ai * 128 + wr * 64 + m * 16 + fr; float q = 0.f, rmx = 0.f;
#pragma unroll
                for (int bj = 0; bj < 2; ++bj) {
                    f32x4 x0, x1;
                    if (IN_BF) { const u32x4 w = xin[m][bj];
                        x0 = (f32x4){__builtin_bit_cast(float, w.x << 16), __builtin_bit_cast(float, w.x & 0xffff0000u), __builtin_bit_cast(float, w.y << 16), __builtin_bit_cast(float, w.y & 0xffff0000u)};
                        x1 = (f32x4){__builtin_bit_cast(float, w.z << 16), __builtin_bit_cast(float, w.z & 0xffff0000u), __builtin_bit_cast(float, w.w << 16), __builtin_bit_cast(float, w.w & 0xffff0000u)}; }
                    else { const f16x8 h = __builtin_bit_cast(f16x8, xin[m][bj]);
                        x0 = (f32x4){(float)h[0], (float)h[1], (float)h[2], (float)h[3]}; x1 = (f32x4){(float)h[4], (float)h[5], (float)h[6], (float)h[7]}; }
                    const f32x4 o0 = x0 + acc[ai][bj][m][0], o1 = x1 + acc[ai][bj][m][1];
                    if (XA != 1 || u.pn * 256 < KF6) *(u32x4*)(xh + (size_t)row * DM + col0 + bj * 128) = pk8t<OUT_BF>(o0, o1);
                    if constexpr (XA == 1) { const int c = col0 + bj * 128;
                        if (u.pn * 256 < KF6) { int w0 = __builtin_amdgcn_cvt_pk_fp8_f32(o0[0] * 4.f, o0[1] * 4.f, 0, false); w0 = __builtin_amdgcn_cvt_pk_fp8_f32(o0[2] * 4.f, o0[3] * 4.f, w0, true);
                            int w1 = __builtin_amdgcn_cvt_pk_fp8_f32(o1[0] * 4.f, o1[1] * 4.f, 0, false); w1 = __builtin_amdgcn_cvt_pk_fp8_f32(o1[2] * 4.f, o1[3] * 4.f, w1, true);
                            u32x2 w; w.x = (unsigned)w0; w.y = (unsigned)w1; *(u32x2*)(xa + (size_t)row * XAB + c) = w; }
                        else *(u32x4*)(xa + (size_t)row * XAB + KF6 + (size_t)(c - KF6) * 2) = pk8t<OUT_BF>(o0, o1); }
                    q += (o0[0] * o0[0] + o0[1] * o0[1]) + (o0[2] * o0[2] + o0[3] * o0[3]) + (o1[0] * o1[0] + o1[1] * o1[1]) + (o1[2] * o1[2] + o1[3] * o1[3]);
                    if constexpr (XA == 3) rmx = fmaxf(rmx, fmaxf(fmaxf(fmaxf(fabsf(o0[0]), fabsf(o0[1])), fmaxf(fabsf(o0[2]), fabsf(o0[3]))), fmaxf(fmaxf(fabsf(o1[0]), fabsf(o1[1])), fmaxf(fabsf(o1[2]), fabsf(o1[3])))));
                }
                q = sum_x16_x32(q);
                if (fq == 0) atomicAdd(ss + row, q);
                if constexpr (XA == 3) { rmx = max_x16_x32(rmx);
                    if (fq == 0) atomicMax((unsigned*)xa + row, __builtin_bit_cast(unsigned, rmx)); }
            }
        }
    }
};
struct EpiGU {
    const float* ss2; f16* Ab; const float* rmax; const float* cmax;
    __device__ __forceinline__ void operator()(const f32x4 (&acc)[2][2][4][2], const Unit& u, int wr, int wc, int fr, int fq) const {
        float ssv[2][4];
#pragma unroll
        for (int ai = 0; ai < 2; ++ai)
#pragma unroll
            for (int m = 0; m < 4; ++m) ssv[ai][m] = (u.half >= 0 && ai == 1) ? 1.f : ss2[u.pm * 256 + (u.half > 0 ? 128 : 0) + ai * 128 + wr * 64 + m * 16 + fr];
        float rmx[2][4]; f32x4 csg[2], csu[2];
        if (GU_I8) {
#pragma unroll
            for (int ai = 0; ai < 2; ++ai)
#pragma unroll
                for (int m = 0; m < 4; ++m) rmx[ai][m] = (u.half >= 0 && ai == 1) ? 1.f : rmax[u.pm * 256 + (u.half > 0 ? 128 : 0) + ai * 128 + wr * 64 + m * 16 + fr];
            const f32x4* cp = (const f32x4*)(cmax + u.pn * 256 + wc * 32 + 8 * fq);
            csg[0] = cp[0] * (1.0f / 127.0f); csg[1] = cp[1] * (1.0f / 127.0f); csu[0] = cp[32] * (1.0f / 127.0f); csu[1] = cp[33] * (1.0f / 127.0f);
        }
#pragma unroll
        for (int ai = 0; ai < 2; ++ai)
#pragma unroll
            for (int m = 0; m < 4; ++m) {
                if (u.half >= 0 && ai == 1) continue;
                const int row = u.pm * 256 + (u.half > 0 ? 128 : 0) + ai * 128 + wr * 64 + m * 16 + fr;
                float r2 = __builtin_amdgcn_rsqf(ssv[ai][m] * (1.0f / DM) + EPS);
                if (GU_I8) r2 *= rmx[ai][m] * (1.0f / 127.0f);
                f32x4 o[2];
#pragma unroll
                for (int n = 0; n < 2; ++n) {
                    if (GU_I8) {
                        const i32x4 gi = __builtin_bit_cast(i32x4, acc[ai][0][m][n]), ui = __builtin_bit_cast(i32x4, acc[ai][1][m][n]);
                        const f32x4 gs = csg[n] * r2, gsn = gs * -1.44269504089f, us = csu[n] * r2;
#pragma unroll
                        for (int e = 0; e < 4; ++e) { const float gf = (float)gi[e], gq = gf * gs[e], ex = __builtin_amdgcn_exp2f(gf * gsn[e]); o[n][e] = gq * ((float)ui[e] * us[e]) * __builtin_amdgcn_rcpf(1.0f + ex); }
                    } else { const f32x4 gq = acc[ai][0][m][n] * r2, uq = acc[ai][1][m][n] * r2;
#pragma unroll
                        for (int e = 0; e < 4; ++e) { const float ex = __builtin_amdgcn_exp2f(gq[e] * -1.44269504089f); o[n][e] = gq[e] * uq[e] * __builtin_amdgcn_rcpf(1.0f + ex); } } }
                const int c = u.pn * 128 + wc * 32 + 8 * fq;
                if (FFN_F8K && u.pn * 128 < KF7) {
                    int w[2];
#pragma unroll
                    for (int n = 0; n < 2; ++n) { f32x4 t;
#pragma unroll
                        for (int e = 0; e < 4; ++e) t[e] = __builtin_amdgcn_fmed3f(o[n][e] * 16.f, -448.f, 448.f);
                        w[n] = __builtin_amdgcn_cvt_pk_fp8_f32(t[0], t[1], 0, false); w[n] = __builtin_amdgcn_cvt_pk_fp8_f32(t[2], t[3], w[n], true); }
                    u32x2 ww; ww.x = (unsigned)w[0]; ww.y = (unsigned)w[1]; *(u32x2*)((unsigned char*)Ab + (size_t)row * ABB + c) = ww;
                } else *(u32x4*)((unsigned char*)Ab + (size_t)row * ABB + KF7 + (size_t)(c - KF7) * 2) = pk8t<FFN_BF16 != 0>(o[0], o[1]);
            }
    }
};

struct Args { const float* in[11]; float* out; unsigned char* ws; float invfA[16]; float invfI[8]; int ph_lo, ph_hi, li, pad; };

struct CvJob { const float* W; const float* gk; f16* Wt; int ldw, K, sc, n, k0, bf; float qs; };
template <int H> __device__ __forceinline__ void cv_issue_half(f32x4 (&r)[16], float (&gs)[16], const CvJob& j, int lane) {
    const float* p = j.W + (size_t)(j.k0 + 32 * H + (lane >> 4)) * j.ldw + (j.sc >= 0 ? j.sc : 0);
#pragma unroll
    for (int i = 0; i < 8; ++i) { r[8 * H + i] = __builtin_nontemporal_load((const f32x4*)p); p += 4 * j.ldw; }
#pragma unroll
    for (int i = 0; i < 8; ++i) gs[8 * H + i] = j.gk ? j.gk[j.k0 + 32 * H + 4 * i + (lane >> 4)] : 1.f;
}
template <bool ZROWS, bool BF> __device__ __forceinline__ void cv_finish(f32x4 (&r)[16], const float (&gs)[16], const CvJob& j) {
    f16* dst = j.Wt + (size_t)j.n * j.K + j.k0;
#pragma unroll
    for (int i = 0; i < 16; ++i) {
        const u32x4 w = __builtin_bit_cast(u32x4, r[i] * gs[i]);
        unsigned e0 = w[0], e1 = w[1], e2 = w[2], e3 = w[3];
        { auto t = __builtin_amdgcn_permlane32_swap(e0, e2, false, false); e0 = t[0]; e2 = t[1]; }
        { auto t = __builtin_amdgcn_permlane32_swap(e1, e3, false, false); e1 = t[0]; e3 = t[1]; }
        { auto t = __builtin_amdgcn_permlane16_swap(e0, e1, false, false); e0 = t[0]; e1 = t[1]; }
        { auto t = __builtin_amdgcn_permlane16_swap(e2, e3, false, false); e2 = t[0]; e3 = t[1]; }
        r[i] = __builtin_bit_cast(f32x4, (u32x4){e0, e1, e2, e3});
    }
#pragma unroll
    for (int q = 0; q < 8; ++q) {
        f32x4 t0 = r[2 * q], t1 = r[2 * q + 1];
        if (ZROWS && j.sc < 0) { t0 = (f32x4){0.f, 0.f, 0.f, 0.f}; t1 = t0; }
        *(u32x4*)(dst + 8 * q) = pk8t<BF>(t0, t1);
    }
}
__device__ __forceinline__ void cv_finish_f8(f32x4 (&r)[16], const float (&gs)[16], const CvJob& j, float scale) {
    unsigned char* dst = (unsigned char*)j.Wt + (size_t)j.n * j.K + j.k0;
#pragma unroll
    for (int i = 0; i < 16; ++i) {
        const u32x4 w = __builtin_bit_cast(u32x4, r[i] * (gs[i] * scale));
        unsigned e0 = w[0], e1 = w[1], e2 = w[2], e3 = w[3];
        { auto t = __builtin_amdgcn_permlane32_swap(e0, e2, false, false); e0 = t[0]; e2 = t[1]; }
        { auto t = __builtin_amdgcn_permlane32_swap(e1, e3, false, false); e1 = t[0]; e3 = t[1]; }
        { auto t = __builtin_amdgcn_permlane16_swap(e0, e1, false, false); e0 = t[0]; e1 = t[1]; }
        { auto t = __builtin_amdgcn_permlane16_swap(e2, e3, false, false); e2 = t[0]; e3 = t[1]; }
        r[i] = __builtin_bit_cast(f32x4, (u32x4){e0, e1, e2, e3});
    }
#pragma unroll
    for (int q = 0; q < 4; ++q) { u32x4 o;
#pragma unroll
        for (int d = 0; d < 4; ++d) { const f32x4 v = r[4 * q + d]; int w0 = __builtin_amdgcn_cvt_pk_fp8_f32(v[0], v[1], 0, false); w0 = __builtin_amdgcn_cvt_pk_fp8_f32(v[2], v[3], w0, true); o[d] = (unsigned)w0; }
        *(u32x4*)(dst + 16 * q) = o; }
}
__device__ __forceinline__ unsigned q8x4(f32x4 v) {
    const unsigned t0 = __builtin_bit_cast(unsigned, v[0] + 12582912.0f), t1 = __builtin_bit_cast(unsigned, v[1] + 12582912.0f), t2 = __builtin_bit_cast(unsigned, v[2] + 12582912.0f), t3 = __builtin_bit_cast(unsigned, v[3] + 12582912.0f);
    return __builtin_amdgcn_perm(t1, t0, 0x0c0c0400u) | __builtin_amdgcn_perm(t3, t2, 0x04000c0cu);
}
__device__ __forceinline__ void cv_finish_i8_64(f32x4 (&r)[16], const float (&gs)[16], const CvJob& j) {
    unsigned char* dst = (unsigned char*)j.Wt + (size_t)j.n * j.K + j.k0;
#pragma unroll
    for (int i = 0; i < 16; ++i) {
        const u32x4 w = __builtin_bit_cast(u32x4, r[i] * gs[i]);
        unsigned e0 = w[0], e1 = w[1], e2 = w[2], e3 = w[3];
        { auto t = __builtin_amdgcn_permlane32_swap(e0, e2, false, false); e0 = t[0]; e2 = t[1]; }
        { auto t = __builtin_amdgcn_permlane32_swap(e1, e3, false, false); e1 = t[0]; e3 = t[1]; }
        { auto t = __builtin_amdgcn_permlane16_swap(e0, e1, false, false); e0 = t[0]; e1 = t[1]; }
        { auto t = __builtin_amdgcn_permlane16_swap(e2, e3, false, false); e2 = t[0]; e3 = t[1]; }
        r[i] = __builtin_bit_cast(f32x4, (u32x4){e0, e1, e2, e3});
    }
    const float s = 127.0f * __builtin_amdgcn_rcpf(fmaxf(j.qs, 1e-30f));
#pragma unroll
    for (int q = 0; q < 4; ++q) { u32x4 o; o.x = q8x4(r[4 * q] * s); o.y = q8x4(r[4 * q + 1] * s); o.z = q8x4(r[4 * q + 2] * s); o.w = q8x4(r[4 * q + 3] * s); *(u32x4*)(dst + 16 * q) = o; }
}
constexpr int CV_IN_N0 = QKV_FP8 ? 3072 : 0;
constexpr int CV_IN_NB = U_I8 ? 20 : (NIN_T - CV_IN_N0) / 64;
constexpr int CV_E_IN = 64 * CV_IN_NB, CV_E_PL = POOL_FOLD ? 0 : 4 * 8 * 8, CV_E_F8 = QKV_FP8 ? 64 * (3072 / 64) : 0, CV_E_O8 = OUT_FP8 ? 32 * 64 : 0, CV_E_U8 = U_I8 ? 64 * 32 : 0, CV_EARLY = CV_E_IN + CV_E_PL + CV_E_F8 + CV_E_O8 + CV_E_U8;
__device__ __forceinline__ void cv_early_job(const Args& a, int it, int lane, CvJob& j) {
    unsigned char* ws = a.ws;
    const int ng = 4 * (lane & 15), nst = ng + (lane >> 4);
    if (it >= CV_E_IN + CV_E_PL + CV_E_F8 + CV_E_O8) { const int r = it - CV_E_IN - CV_E_PL - CV_E_F8 - CV_E_O8, kb = r >> 5, nb = r & 31;
        j.W = a.in[2]; j.gk = a.in[1]; j.Wt = (f16*)(ws + WS_W8I); j.ldw = IN_W; j.K = DM; j.n = nb * 64 + nst; j.k0 = kb * 64; j.bf = 3; j.sc = 4176 + nb * 64 + ng;
        j.qs = ((const float*)(ws + WS_CTL + CTL_CMAXU))[j.n]; return; }
    if (it >= CV_E_IN + CV_E_PL + CV_E_F8) { const int r = it - CV_E_IN - CV_E_PL - CV_E_F8, kb = r >> 6, nb = r & 63;
        j.W = a.in[5]; j.gk = nullptr; j.Wt = (f16*)(ws + WS_WOUT + (OUT_I8P ? 2048 : 0)); j.ldw = DM; j.K = MIXB; j.n = nb * 64 + nst; j.k0 = kb * 64; j.bf = 2; j.sc = nb * 64 + ng; return; }
    if (it >= CV_E_IN + CV_E_PL) { const int r = it - CV_E_IN - CV_E_PL, nblk = 3072 / 64, kb = r / nblk, nb = r % nblk;
        j.W = a.in[2]; j.gk = a.in[1]; j.Wt = (f16*)(ws + WS_W8); j.ldw = IN_W; j.K = DM; j.n = nb * 64 + nst; j.k0 = kb * 64; j.bf = QKV_I8 ? 3 : 2; j.sc = nb * 64 + ng;
        if (QKV_I8) j.qs = ((const float*)(ws + WS_CTL + CTL_CMAXQ))[j.n]; return; }
    if (it < CV_E_IN) { const int nblk = CV_IN_NB, kb = it / nblk, nbi = it % nblk, nb = U_I8 ? (nbi < 16 ? 48 + nbi : 80 + nbi) : nbi + CV_IN_N0 / 64, n = nb * 64 + ng;
        j.W = a.in[2]; j.gk = a.in[1]; j.Wt = (f16*)(ws + WS_WIN); j.ldw = IN_W; j.K = DM; j.n = nb * 64 + nst; j.k0 = kb * 64; j.bf = 0;
        j.sc = n < 4096 ? n : n < 6144 ? n + 80 : n < 6224 ? n - 2048 : -1; }
    else { const int r = it - CV_E_IN, gq = r >> 6, kb = (r >> 3) & 7, nb = r & 7;
        j.W = a.in[3] + (size_t)gq * 512 * 512; j.gk = nullptr; j.Wt = (f16*)(ws + WS_WPOOL) + (size_t)gq * 512 * 512; j.ldw = 512; j.K = 512; j.n = nb * 64 + nst; j.k0 = kb * 64; j.bf = 0; j.sc = nb * 64 + ng; }
}
constexpr int CV_L_OUT = 64 * 64, CV_L_GU = 64 * (NGU / 64), CV_L_DN = (DFF / 64) * 64, CV_LATE = CV_L_OUT + CV_L_GU + CV_L_DN;
__device__ __forceinline__ void cv_late_job(const Args& a, int it, int lane, CvJob& j) {
    unsigned char* ws = a.ws;
    const int ng = 4 * (lane & 15), nst = ng + (lane >> 4);
    if (it < CV_L_OUT) { const int kb = it >> 6, nb = it & 63;
        j.W = a.in[5]; j.gk = nullptr; j.Wt = (f16*)(ws + WS_WOUT); j.ldw = DM; j.K = DM; j.n = nb * 64 + nst; j.sc = nb * 64 + ng; j.k0 = kb * 64; j.bf = 0; return; }
    it -= CV_L_OUT;
    if (it < CV_L_GU) { const int nblk = NGU / 64, kb = it / nblk, nb = it % nblk, n0 = nb * 64, pn = n0 >> 8, rho = n0 & 255;
        j.W = rho < 128 ? a.in[7] : a.in[8]; j.gk = a.in[6]; j.Wt = (f16*)(ws + WS_WGU); j.ldw = DFF; j.K = DM; j.n = n0 + nst; j.sc = pn * 128 + (rho & 127) + ng; j.k0 = kb * 64; j.bf = FFN_BF16; return; }
    it -= CV_L_GU;
    { const int kb = it >> 6, nb = it & 63;
        j.W = a.in[9]; j.gk = nullptr; j.Wt = (f16*)(ws + WS_WDN); j.ldw = DM; j.K = DFF; j.n = nb * 64 + nst; j.sc = nb * 64 + ng; j.k0 = kb * 64; j.bf = FFN_BF16; }
}

constexpr int CV32_OUT = ((OUT_FP8 ? DM / 2 : DM) / 32) * 64, CV32_GU = (DM / 32) * (NGU / 64), CV32_DN = (DFF / 32) * 64, CV32_LATE = CV32_OUT + CV32_GU + CV32_DN;
__device__ __forceinline__ void cv32_job(const Args& a, int it, int lane, CvJob& j) {
    unsigned char* ws = a.ws; const int ng = 4 * (lane & 15), nst = ng + (lane >> 4);
    if (it < CV32_OUT) { const int kb = it >> 6, nb = it & 63;
        if (OUT_FP8 && POOL_FOLD) { j.W = a.in[5]; j.gk = nullptr; j.Wt = (f16*)(ws + WS_WORAW) - 2048; j.ldw = DM; j.K = 2048; j.n = nb * 64 + nst; j.sc = nb * 64 + ng; j.k0 = 2048 + kb * 32; j.bf = 0; return; }
        if (OUT_FP8) { j.W = a.in[5]; j.gk = nullptr; j.Wt = (f16*)(ws + WS_WOUT) - 1024; j.ldw = DM; j.K = MIXB / 2; j.n = nb * 64 + nst; j.sc = nb * 64 + ng; j.k0 = 2048 + kb * 32; j.bf = 0; return; }
        j.W = a.in[5]; j.gk = nullptr; j.Wt = (f16*)(ws + WS_WOUT); j.ldw = DM; j.K = DM; j.n = nb * 64 + nst; j.sc = nb * 64 + ng; j.k0 = kb * 32; j.bf = 0; return; }
    it -= CV32_OUT;
    if (it < CV32_GU) { const int nblk = NGU / 64, kb = it / nblk, nb = it % nblk, n0 = nb * 64, pn = n0 >> 8, rho = n0 & 255;
        j.W = rho < 128 ? a.in[7] : a.in[8]; j.gk = a.in[6]; j.ldw = DFF; j.n = n0 + nst; j.sc = pn * 128 + (rho & 127) + ng; j.k0 = kb * 32;
        if (GU_I8) { j.Wt = (f16*)(ws + WS_WGU); j.K = DM; j.bf = 3; }
        else if (kb * 32 < KF6) { j.Wt = (f16*)(ws + WS_WGU); j.K = XAB; j.bf = 2; }
        else { j.Wt = (f16*)(ws + WS_WGU) - KF6 / 2; j.K = XAB / 2; j.bf = FFN_BF16; }
        return; }
    it -= CV32_GU;
    { const int kb = it >> 6, nb = it & 63;
        j.W = a.in[9]; j.gk = nullptr; j.ldw = DM; j.n = nb * 64 + nst; j.sc = nb * 64 + ng; j.k0 = kb * 32;
        if (kb * 32 < KF7) { j.Wt = (f16*)(ws + WS_WDN); j.K = ABB; j.bf = 2; }
        else { j.Wt = (f16*)(ws + WS_WDN) - KF7 / 2; j.K = ABB / 2; j.bf = FFN_BF16; } }
}
__device__ __forceinline__ void cv32_issue(f32x4 (&r)[8], float (&gs)[8], CvJob& j, int lane, const float* cmax = nullptr) {
    j.qs = (GU_I8 && j.bf == 3 && cmax) ? cmax[j.n] : 1.f;
    const float* p = j.W + (size_t)(j.k0 + (lane >> 4)) * j.ldw + j.sc;
#pragma unroll
    for (int i = 0; i < 8; ++i) { r[i] = __builtin_nontemporal_load((const f32x4*)p); p += 4 * j.ldw; }
#pragma unroll
    for (int i = 0; i < 8; ++i) gs[i] = j.gk ? j.gk[j.k0 + 4 * i + (lane >> 4)] : 1.f;
}
template <bool BF> __device__ __forceinline__ void cv32_finish(f32x4 (&r)[8], const float (&gs)[8], const CvJob& j) {
    f16* dst = j.Wt + (size_t)j.n * j.K + j.k0;
#pragma unroll
    for (int i = 0; i < 8; ++i) {
        const u32x4 w = __builtin_bit_cast(u32x4, r[i] * gs[i]);
        unsigned e0 = w[0], e1 = w[1], e2 = w[2], e3 = w[3];
        { auto t = __builtin_amdgcn_permlane32_swap(e0, e2, false, false); e0 = t[0]; e2 = t[1]; }
        { auto t = __builtin_amdgcn_permlane32_swap(e1, e3, false, false); e1 = t[0]; e3 = t[1]; }
        { auto t = __builtin_amdgcn_permlane16_swap(e0, e1, false, false); e0 = t[0]; e1 = t[1]; }
        { auto t = __builtin_amdgcn_permlane16_swap(e2, e3, false, false); e2 = t[0]; e3 = t[1]; }
        r[i] = __builtin_bit_cast(f32x4, (u32x4){e0, e1, e2, e3});
    }
#pragma unroll
    for (int q = 0; q < 4; ++q) *(u32x4*)(dst + 8 * q) = pk8t<BF>(r[2 * q], r[2 * q + 1]);
}
__device__ __forceinline__ void cv32_finish_i8(f32x4 (&r)[8], const float (&gs)[8], const CvJob& j) {
    unsigned char* dst = (unsigned char*)j.Wt + (size_t)j.n * j.K + j.k0;
#pragma unroll
    for (int i = 0; i < 8; ++i) {
        const u32x4 w = __builtin_bit_cast(u32x4, r[i] * gs[i]);
        unsigned e0 = w[0], e1 = w[1], e2 = w[2], e3 = w[3];
        { auto t = __builtin_amdgcn_permlane32_swap(e0, e2, false, false); e0 = t[0]; e2 = t[1]; }
        { auto t = __builtin_amdgcn_permlane32_swap(e1, e3, false, false); e1 = t[0]; e3 = t[1]; }
        { auto t = __builtin_amdgcn_permlane16_swap(e0, e1, false, false); e0 = t[0]; e1 = t[1]; }
        { auto t = __builtin_amdgcn_permlane16_swap(e2, e3, false, false); e2 = t[0]; e3 = t[1]; }
        r[i] = __builtin_bit_cast(f32x4, (u32x4){e0, e1, e2, e3});
    }
    const float s = 127.0f * __builtin_amdgcn_rcpf(fmaxf(j.qs, 1e-30f));
#pragma unroll
    for (int q = 0; q < 4; ++q) { u32x2 o; o.x = q8x4(r[2 * q] * s); o.y = q8x4(r[2 * q + 1] * s); *(u32x2*)(dst + 8 * q) = o; }
}
__device__ __forceinline__ void cv32_finish_f8(f32x4 (&r)[8], const float (&gs)[8], const CvJob& j) {
    unsigned char* dst = (unsigned char*)j.Wt + (size_t)j.n * j.K + j.k0;
#pragma unroll
    for (int i = 0; i < 8; ++i) {
        const u32x4 w = __builtin_bit_cast(u32x4, r[i] * (gs[i] * 64.f));
        unsigned e0 = w[0], e1 = w[1], e2 = w[2], e3 = w[3];
        { auto t = __builtin_amdgcn_permlane32_swap(e0, e2, false, false); e0 = t[0]; e2 = t[1]; }
        { auto t = __builtin_amdgcn_permlane32_swap(e1, e3, false, false); e1 = t[0]; e3 = t[1]; }
        { auto t = __builtin_amdgcn_permlane16_swap(e0, e1, false, false); e0 = t[0]; e1 = t[1]; }
        { auto t = __builtin_amdgcn_permlane16_swap(e2, e3, false, false); e2 = t[0]; e3 = t[1]; }
        r[i] = __builtin_bit_cast(f32x4, (u32x4){e0, e1, e2, e3});
    }
#pragma unroll
    for (int q = 0; q < 4; ++q) { u32x2 o;
#pragma unroll
        for (int d = 0; d < 2; ++d) { const f32x4 v = r[2 * q + d]; int w0 = __builtin_amdgcn_cvt_pk_fp8_f32(v[0], v[1], 0, false); w0 = __builtin_amdgcn_cvt_pk_fp8_f32(v[2], v[3], w0, true); o[d] = (unsigned)w0; }
        *(u32x2*)(dst + 8 * q) = o; }
}

__device__ __forceinline__ void p0_convert(const Args& a, int vcu, int G, int wave, int lane) {
    const int gw = vcu * NWAVES + wave, NGW = G * NWAVES;
    for (int it = gw; it < CV_EARLY; it += NGW) { CvJob j; f32x4 v[16]; float gs[16]; cv_early_job(a, it, lane, j); cv_issue_half<0>(v, gs, j, lane); cv_issue_half<1>(v, gs, j, lane); if (U_I8 && j.bf == 3) cv_finish_i8_64(v, gs, j); else if (j.bf == 2) cv_finish_f8(v, gs, j, 64.f); else cv_finish<true, false>(v, gs, j); }
}
__device__ __forceinline__ void p0_prologue(const Args& a, LAS unsigned char* lds, int vcu, int G, int wave, int lane) {
    unsigned char* ws = a.ws;
    const float* x = a.in[0];
    const int gw = vcu * NWAVES + wave, NGW = G * NWAVES;
    if (!U_I8) p0_convert(a, vcu, G, wave, lane);
    if (POOL_FOLD) {
        const float* wp = a.in[3]; const float* ps = a.in[4]; f16* o = (f16*)(ws + WS_WPOOL);
        for (int e = (gw * 64 + lane) * 8; e < 4 * 512 * 512; e += NGW * 64 * 8) { const int g = e >> 18, d = e & 511;
            const f32x4 w0 = *(const f32x4*)(wp + e), w1 = *(const f32x4*)(wp + e + 4), p0 = *(const f32x4*)(ps + g * 512 + d), p1 = *(const f32x4*)(ps + g * 512 + d + 4);
            *(u32x4*)(o + e) = pk8t<FFN_BF16 != 0>(w0 * p0, w1 * p1); }
    }
    if (GU_I8) {
        float* cmax = (float*)(ws + WS_CTL + CTL_CMAX);
        for (int it = gw; it < 2 * 43 * 32; it += NGW) {
            const int mat = it / (43 * 32), r = it % (43 * 32), cb = r >> 5, kc = r & 31;
            const float* W = (mat ? a.in[8] : a.in[7]) + (size_t)(kc * 128) * DFF + cb * 256 + 4 * lane; const float* gk = a.in[6] + kc * 128;
            f32x4 mx = {0.f, 0.f, 0.f, 0.f};
#pragma unroll 1
            for (int kk = 0; kk < 128; kk += 16) { f32x4 v[16];
#pragma unroll
                for (int j = 0; j < 16; ++j) v[j] = *(const f32x4*)(W + (size_t)(kk + j) * DFF);
#pragma unroll
                for (int j = 0; j < 16; ++j) { const float g = fabsf(gk[kk + j]);
#pragma unroll
                    for (int e = 0; e < 4; ++e) mx[e] = fmaxf(mx[e], fabsf(v[j][e]) * g); } }
            const int c = cb * 256 + 4 * lane, row = (c >> 7) * 256 + mat * 128 + (c & 127);
            const u32x4 mb = __builtin_bit_cast(u32x4, mx);
#pragma unroll
            for (int e = 0; e < 4; ++e) atomicMax((unsigned*)cmax + row + e, mb[e]);
        }
    }
    if (U_I8) {
        for (int it = gw; it < (QKV_I8 ? 20 : 8) * 32; it += NGW) {
            const int cb0 = it >> 5, kc = it & 31, isq = cb0 >= 8, cb = isq ? cb0 - 8 : cb0;
            float* cmaxu = (float*)(ws + WS_CTL + (isq ? CTL_CMAXQ : CTL_CMAXU));
            const float* W = a.in[2] + (size_t)(kc * 128) * IN_W + (isq ? 0 : 4176) + cb * 256 + 4 * lane; const float* gk = a.in[1] + kc * 128;
            f32x4 mx = {0.f, 0.f, 0.f, 0.f};
#pragma unroll 1
            for (int kk = 0; kk < 128; kk += 16) { f32x4 v[16];
#pragma unroll
                for (int j = 0; j < 16; ++j) v[j] = *(const f32x4*)(W + (size_t)(kk + j) * IN_W);
#pragma unroll
                for (int j = 0; j < 16; ++j) { const float g = fabsf(gk[kk + j]);
#pragma unroll
                    for (int e = 0; e < 4; ++e) mx[e] = fmaxf(mx[e], fabsf(v[j][e]) * g); } }
            const u32x4 mb = __builtin_bit_cast(u32x4, mx);
#pragma unroll
            for (int e = 0; e < 4; ++e) atomicMax((unsigned*)cmaxu + cb * 256 + 4 * lane + e, mb[e]);
        }
    }
    f16* XH = (f16*)(ws + WS_XH); float* R1 = (float*)(ws + WS_R1);
    for (int m = gw; m < M; m += NGW) {
        const f32x4* xr = (const f32x4*)(x + (size_t)m * DM) + lane; u32x2* o8 = (u32x2*)(XH + (size_t)m * DM) + lane; float s = 0.f;
        f32x4 xv[16];
#pragma unroll
        for (int j = 0; j < 16; ++j) xv[j] = __builtin_nontemporal_load(xr + 64 * j);
        asm volatile("" ::: "memory");
#pragma unroll
        for (int j = 0; j < 16; ++j) { const f32x4 v = xv[j]; s += (v[0] * v[0] + v[1] * v[1]) + (v[2] * v[2] + v[3] * v[3]); u32x2 w; w.x = pkh(v[0], v[1]); w.y = pkh(v[2], v[3]); o8[64 * j] = w;
            if (QKV_FP8 && !QKV_I8) { int w8 = __builtin_amdgcn_cvt_pk_fp8_f32(v[0], v[1], 0, false); w8 = __builtin_amdgcn_cvt_pk_fp8_f32(v[2], v[3], w8, true); ((unsigned*)(ws + WS_X8 + (size_t)m * DM))[lane + 64 * j] = (unsigned)w8; } }
        s = wave_sum(s);
        if (lane == 0) R1[m] = 1.0f / sqrtf(s * (1.0f / DM) + EPS);
        if (U_I8) {
            float mxl = 0.f;
#pragma unroll
            for (int j = 0; j < 16; ++j) mxl = fmaxf(mxl, fmaxf(fmaxf(fabsf(xv[j][0]), fabsf(xv[j][1])), fmaxf(fabsf(xv[j][2]), fabsf(xv[j][3]))));
#pragma unroll
            for (int o = 32; o > 0; o >>= 1) mxl = fmaxf(mxl, __shfl_xor(mxl, o));
            const float s8 = 127.0f * __builtin_amdgcn_rcpf(fmaxf(mxl, 1e-30f));
            if (lane == 0) { ((float*)(ws + WS_XMAX))[m] = mxl; ((float*)(ws + WS_R1X))[m] = (1.0f / sqrtf(s * (1.0f / DM) + EPS)) * mxl * (1.0f / 127.0f); }
#pragma unroll
            for (int j = 0; j < 16; ++j) ((unsigned*)(ws + WS_X8I + (size_t)m * DM))[lane + 64 * j] = q8x4(xv[j] * s8);
        }
    }
    const int gt = gw * 64 + lane, NGT = NGW * 64;
    float* cosA = (float*)(ws + WS_COSA); float* sinA = (float*)(ws + WS_SINA); float* cosI = (float*)(ws + WS_COSI); float* sinI = (float*)(ws + WS_SINI);
    for (int e = gt; e < SEQ * 24; e += NGT) {
        double s, c;
        if (e < SEQ * 16) { const int t = e >> 4, i = e & 15; const float ang = (float)t * a.invfA[i]; sincos_d((double)ang, s, c); cosA[e] = (float)c; sinA[e] = (float)s; }
        else { const int e2 = e - SEQ * 16, t = e2 >> 3, i = e2 & 7; const float ang = (float)t * a.invfI[i]; sincos_d((double)ang, s, c); cosI[e2] = (float)c; sinI[e2] = (float)s; }
    }
}

template <int W> __device__ __forceinline__ void pd_sum_prev(const f16* p, float (&s)[8]) {
    f16x8 v[W - 1];
#pragma unroll
    for (int j = 0; j < W - 1; ++j) v[j] = *(const f16x8*)(p - (size_t)(j + 1) * NU);
#pragma unroll
    for (int j = 0; j < W - 1; ++j)
#pragma unroll
        for (int e = 0; e < 8; ++e) s[e] += (float)v[j][e];
}
template <bool TO_MIX> __device__ __forceinline__ void pool_diff_phase(const f16* U, f16* PD, int vcu, int G, int tid, size_t lo = 0, size_t hi = (size_t)M * 256, float* dmax = nullptr) {
    const size_t nth = (size_t)G * 512, gt = (size_t)vcu * 512 + tid;
    for (size_t it = lo + gt; it < hi; it += nth) {
        const int row = (int)(it >> 8), ch = (int)(it & 255), t = row & (SEQ - 1), grp = ch >> 6, w = 2 << grp, cnt = (t + 1) < w ? (t + 1) : w;
        const f16* p = U + (size_t)row * NU + ch * 8;
        const f16x8 cur = *(const f16x8*)p; float s[8];
#pragma unroll
        for (int e = 0; e < 8; ++e) s[e] = (float)cur[e];
        if (t >= 15) { if (grp == 0) pd_sum_prev<2>(p, s); else if (grp == 1) pd_sum_prev<4>(p, s); else if (grp == 2) pd_sum_prev<8>(p, s); else pd_sum_prev<16>(p, s); }
        else for (int j = 1; j < cnt; ++j) { const f16x8 v = *(const f16x8*)(p - (size_t)j * NU);
#pragma unroll
            for (int e = 0; e < 8; ++e) s[e] += (float)v[e]; }
        const float inv = 1.0f / (float)cnt; f32x4 d0, d1;
#pragma unroll
        for (int e = 0; e < 4; ++e) { d0[e] = s[e] * inv - (float)cur[e]; d1[e] = s[e + 4] * inv - (float)cur[e + 4]; }
        if (OUT_I8P && dmax) { *(u32x4*)(PD + (size_t)row * NU + ch * 8) = pk8t<FFN_BF16 != 0>(d0, d1);
            float mx = fmaxf(fmaxf(fmaxf(fabsf(d0[0]), fabsf(d0[1])), fmaxf(fabsf(d0[2]), fabsf(d0[3]))), fmaxf(fmaxf(fabsf(d1[0]), fabsf(d1[1])), fmaxf(fabsf(d1[2]), fabsf(d1[3]))));
#pragma unroll
            for (int o = 32; o > 0; o >>= 1) mx = fmaxf(mx, __shfl_xor(mx, o));
            if ((tid & 63) == 0) atomicMax((unsigned*)dmax + row, __builtin_bit_cast(unsigned, mx)); }
        else if (TO_MIX) *(u32x4*)(PD + (size_t)row * (MIXB / 2) + MIX_POOL0 + ch * 8) = pk8t<FFN_BF16 != 0>(d0, d1);
        else *(u32x4*)(PD + (size_t)row * NU + ch * 8) = pk8(d0, d1);
    }
}

template <int GRP> __device__ __forceinline__ void pd_group(const f16* U, int m, int t, int lane, f32x4& d0, f32x4& d1) {
    constexpr int W = 2 << GRP; const int cnt = (t + 1) < W ? (t + 1) : W;
    const f16* p = U + (size_t)m * NU + (GRP * 64 + lane) * 8;
    const f16x8 cur = *(const f16x8*)p; float s[8];
#pragma unroll
    for (int e = 0; e < 8; ++e) s[e] = (float)cur[e];
    if (t >= 15) pd_sum_prev<W>(p, s);
    else for (int j = 1; j < cnt; ++j) { const f16x8 v = *(const f16x8*)(p - (size_t)j * NU);
#pragma unroll
        for (int e = 0; e < 8; ++e) s[e] += (float)v[e]; }
    const float inv = 1.0f / (float)cnt;
#pragma unroll
    for (int e = 0; e < 4; ++e) { d0[e] = s[e] * inv - (float)cur[e]; d1[e] = s[e + 4] * inv - (float)cur[e + 4]; }
}
__device__ __forceinline__ void pool_diff_rows_i8(const f16* U, unsigned char* mix, float* dmax, int w0, int nw, int lane, int row_lo, int row_hi) {
    for (int m = row_lo + w0; m < row_hi; m += nw) {
        const int t = m & (SEQ - 1);
        f32x4 d[4][2];
        pd_group<0>(U, m, t, lane, d[0][0], d[0][1]); pd_group<1>(U, m, t, lane, d[1][0], d[1][1]); pd_group<2>(U, m, t, lane, d[2][0], d[2][1]); pd_group<3>(U, m, t, lane, d[3][0], d[3][1]);
        float mx = 0.f;
#pragma unroll
        for (int g = 0; g < 4; ++g)
#pragma unroll
            for (int h = 0; h < 2; ++h) mx = fmaxf(mx, fmaxf(fmaxf(fabsf(d[g][h][0]), fabsf(d[g][h][1])), fmaxf(fabsf(d[g][h][2]), fabsf(d[g][h][3]))));
#pragma unroll
        for (int o = 32; o > 0; o >>= 1) mx = fmaxf(mx, __shfl_xor(mx, o));
        const float s8 = 127.0f * __builtin_amdgcn_rcpf(fmaxf(mx, 1e-30f));
        if (lane == 0) dmax[m] = mx;
#pragma unroll
        for (int g = 0; g < 4; ++g) { u32x2 q; q.x = q8x4(d[g][0] * s8); q.y = q8x4(d[g][1] * s8); *(u32x2*)(mix + (size_t)m * MIXB + (g * 64 + lane) * 8) = q; }
    }
}

constexpr int IDX_CAP = 768, IDX_CH = 256, IDX_NE = IDX_CAP / 64;
constexpr int IDX_LDS_IK = 0, IDX_LDS_SC = 2 * IDX_CH * 128  , IDX_LDS_IX = IDX_LDS_SC + 16 * IDX_CAP * 4  , IDX_LDS_END = IDX_LDS_IX + 16 * IDX_CAP * 2  ;
static_assert(IDX_LDS_END <= SCRATCH_BYTES, "indexer LDS");
__device__ __forceinline__ unsigned ord_key(float f) { const unsigned b = __builtin_bit_cast(unsigned, f); return (b & 0x80000000u) ? ~b : (b | 0x80000000u); }
__device__ __forceinline__ float ord_val(unsigned k) { const unsigned b = (k & 0x80000000u) ? (k & 0x7fffffffu) : ~k; return __builtin_bit_cast(float, b); }

__device__ __forceinline__ int wave_sum_i(int v) {
    v += __builtin_amdgcn_update_dpp(0, v, 0xB1, 0xF, 0xF, false);
    v += __builtin_amdgcn_update_dpp(0, v, 0x4E, 0xF, 0xF, false);
    v += __builtin_amdgcn_update_dpp(0, v, 0x141, 0xF, 0xF, false);
    v += __builtin_amdgcn_update_dpp(0, v, 0x140, 0xF, 0xF, false);
    return __builtin_amdgcn_readlane(v, 0) + __builtin_amdgcn_readlane(v, 16) + __builtin_amdgcn_readlane(v, 32) + __builtin_amdgcn_readlane(v, 48);
}
template <int NBITS>
__device__ __forceinline__ int list_select(LAS float* sc, LAS u16* ix, int n, int lane, float& thr) {
    unsigned key[IDX_NE]; unsigned id[IDX_NE];
#pragma unroll
    for (int i = 0; i < IDX_NE; ++i) { const int e = lane + 64 * i; if (e < n) { key[i] = ord_key(sc[e]); id[i] = ix[e]; } else { key[i] = 0u; id[i] = 0u; } }
    unsigned T = 0u;
#pragma unroll 1
    for (int bit = 31; bit >= 32 - NBITS; --bit) {
        const unsigned cand = T | (1u << bit); int c = 0;
#pragma unroll
        for (int i0 = 0; i0 < IDX_NE; i0 += 6) { unsigned long long mk[6];
            asm("v_cmp_le_u32_e64 %0, %6, %7\n\tv_cmp_le_u32_e64 %1, %6, %8\n\tv_cmp_le_u32_e64 %2, %6, %9\n\tv_cmp_le_u32_e64 %3, %6, %10\n\tv_cmp_le_u32_e64 %4, %6, %11\n\tv_cmp_le_u32_e64 %5, %6, %12"
                : "=&s"(mk[0]), "=&s"(mk[1]), "=&s"(mk[2]), "=&s"(mk[3]), "=&s"(mk[4]), "=&s"(mk[5]) : "s"(cand), "v"(key[i0]), "v"(key[i0 + 1]), "v"(key[i0 + 2]), "v"(key[i0 + 3]), "v"(key[i0 + 4]), "v"(key[i0 + 5]));
#pragma unroll
            for (int i = 0; i < 6; ++i) c += __builtin_popcountll(mk[i]); }
        if (c >= TOPK) T = cand;
        if (c == TOPK) break;
    }
    LDS_WAIT(); asm volatile("" ::: "memory");
    int pos = 0;
#pragma unroll
    for (int i = 0; i < IDX_NE; ++i) {
        const bool pr = (lane + 64 * i < n) && key[i] >= T; const unsigned long long mk = __ballot(pr);
        const int rank = __popcll(mk & ((1ull << lane) - 1ull));
        if (pr) { sc[pos + rank] = ord_val(key[i]); ix[pos + rank] = (u16)id[i]; }
        pos += __popcll(mk);
    }
    LDS_WAIT(); asm volatile("" ::: "memory");
    thr = ord_val(T);
    return pos;
}
__device__ __forceinline__ void list_final(LAS float* sc, LAS u16* ix, int n, int lane, u16* out) {
    unsigned key[IDX_NE]; unsigned id[IDX_NE];
#pragma unroll
    for (int i = 0; i < IDX_NE; ++i) { const int e = lane + 64 * i; if (e < n) { key[i] = ord_key(sc[e]); id[i] = ix[e]; } else { key[i] = 0u; id[i] = 0u; } }
    unsigned T = 0u;
#pragma unroll 1
    for (int bit = 31; bit >= 0; --bit) {
        const unsigned cand = T | (1u << bit); int c = 0;
#pragma unroll
        for (int i0 = 0; i0 < IDX_NE; i0 += 6) { unsigned long long mk[6];
            asm("v_cmp_le_u32_e64 %0, %6, %7\n\tv_cmp_le_u32_e64 %1, %6, %8\n\tv_cmp_le_u32_e64 %2, %6, %9\n\tv_cmp_le_u32_e64 %3, %6, %10\n\tv_cmp_le_u32_e64 %4, %6, %11\n\tv_cmp_le_u32_e64 %5, %6, %12"
                : "=&s"(mk[0]), "=&s"(mk[1]), "=&s"(mk[2]), "=&s"(mk[3]), "=&s"(mk[4]), "=&s"(mk[5]) : "s"(cand), "v"(key[i0]), "v"(key[i0 + 1]), "v"(key[i0 + 2]), "v"(key[i0 + 3]), "v"(key[i0 + 4]), "v"(key[i0 + 5]));
#pragma unroll
            for (int i = 0; i < 6; ++i) c += __builtin_popcountll(mk[i]); }
        if (c >= TOPK) T = cand;
        if (c == TOPK) break;
    }
    int cgt = 0;
#pragma unroll
    for (int i = 0; i < IDX_NE; ++i) cgt += __popcll(__ballot((lane + 64 * i < n) && key[i] > T));
    int pg = 0, pe = cgt;
#pragma unroll
    for (int i = 0; i < IDX_NE; ++i) {
        const bool val = (lane + 64 * i < n), gt = val && key[i] > T, eq = val && key[i] == T;
        const unsigned long long mg = __ballot(gt), me = __ballot(eq), lt = (1ull << lane) - 1ull;
        const int rg = pg + __popcll(mg & lt), re = pe + __popcll(me & lt);
        if (gt) out[rg] = (u16)id[i];
        if (eq && re < TOPK) out[re] = (u16)id[i];
        pg += __popcll(mg); pe += __popcll(me);
    }
}

struct CvRun { int next, stride, tick, pend; };

template <int PMODE = 0> __device__ __forceinline__ void indexer_unit(const Args& a, CvRun& cv, const f16* IQ, const f16* IK, const float* IW, u16* TK, LAS unsigned char* lds, int b, int qt, int tid, int wave, int lane) {
    const int t0 = qt * 16, m0 = b * SEQ + t0, hh = lane >> 5, l31 = lane & 31;
    const int myq = 2 * wave + hh, tq = t0 + myq;
    const int aq = (l31 >> 2) & 1, ah = (l31 & 3) + 4 * (l31 >> 3);
    const f16* iqp = IQ + (size_t)(m0 + 2 * wave + aq) * NIQ + ah * 64 + 8 * hh;
    f16x8 afr[4];
#pragma unroll
    for (int s = 0; s < 4; ++s) afr[s] = *(const f16x8*)(iqp + 16 * s);
    float wv[16];
    { const f32x4* wp = (const f32x4*)(IW + (size_t)(m0 + myq) * NIW);
#pragma unroll
      for (int i = 0; i < 4; ++i) { const f32x4 v = wp[i]; wv[4 * i] = v[0] * 0.03125f; wv[4 * i + 1] = v[1] * 0.03125f; wv[4 * i + 2] = v[2] * 0.03125f; wv[4 * i + 3] = v[3] * 0.03125f; } }
    LAS float* scq = (LAS float*)(lds + IDX_LDS_SC) + myq * IDX_CAP; LAS u16* ixq = (LAS u16*)(lds + IDX_LDS_IX) + myq * IDX_CAP;
    int cnt = 0; float thr = -INFINITY;
    const int nkeys = t0 + 16, nch = (nkeys + IDX_CH - 1) / IDX_CH;
    const f16* ikb = IK + (size_t)b * SEQ * NIK;
    int boffs[4];
#pragma unroll
    for (int s = 0; s < 4; ++s) boffs[s] = 128 * l31 + 16 * ((2 * s + hh) ^ ((l31 >> 1) & 7));
#define IDX_DMA(c_) do { _Pragma("unroll") for (int i_ = 0; i_ < 4; ++i_) { const int j_ = wave * 4 + i_, r_ = 8 * j_ + (lane >> 3); \
        __builtin_amdgcn_global_load_lds((const unsigned*)(ikb + (size_t)((c_) * IDX_CH + r_) * NIK + 8 * ((lane & 7) ^ ((r_ >> 1) & 7))), (LAS unsigned*)(lds + IDX_LDS_IK + ((c_) & 1) * 32768 + 1024 * j_), 16, 0, 0); } } while (0)
    __syncthreads();
    int young = 0;
    IDX_DMA(0);
    for (int c = 0; c < nch; ++c) {
        if (young == 4) asm volatile("s_waitcnt vmcnt(4) lgkmcnt(0)\n\ts_barrier" ::: "memory");
        else asm volatile("s_waitcnt vmcnt(0) lgkmcnt(0)\n\ts_barrier" ::: "memory");
        young = 0;
        if (c + 1 < nch) IDX_DMA(c + 1);
        const bool cvh = (PMODE == 0) && cv.next < CV32_LATE;
        CvJob cj; f32x4 cvv[8]; float cvg[8];
        if (cvh) { cv32_job(a, cv.next, lane, cj); cv32_issue(cvv, cvg, cj, lane, (const float*)(a.ws + WS_CTL + CTL_CMAX)); cv.next += cv.stride; }
        const bool forced = (c == 3) | (c == 6) | (c == 12) | (c == 24);
#pragma unroll 1
        for (int h2 = 0; h2 < 2; ++h2) {
            const int ch = __builtin_amdgcn_readlane(cnt, 32 * h2);
            if (PMODE != 1 && ((forced && ch > TOPK) || ch + IDX_CH > IDX_CAP)) {
                LAS float* s2 = (LAS float*)(lds + IDX_LDS_SC) + (2 * wave + h2) * IDX_CAP; LAS u16* i2 = (LAS u16*)(lds + IDX_LDS_IX) + (2 * wave + h2) * IDX_CAP;
                float th; int nn = list_select<12>(s2, i2, ch, lane, th);
                if (nn + IDX_CH > IDX_CAP) nn = list_select<32>(s2, i2, nn, lane, th);
                if (hh == h2) { cnt = nn; thr = th; }
            }
        }
        const int kbase = c * IDX_CH; int ntile = (nkeys - kbase + 31) >> 5; ntile = ntile > 8 ? 8 : ntile; if (PMODE == 2) ntile = 0;
        const LAS unsigned char* cb = lds + IDX_LDS_IK + (c & 1) * 32768;
        f16x8 bfr[4];
#pragma unroll
        for (int s = 0; s < 4; ++s) bfr[s] = *(const LAS f16x8*)(cb + boffs[s]);
#pragma unroll 1
        for (int tl = 0; tl < ntile; ++tl) {
            f32x16 acc;
#pragma unroll
            for (int r = 0; r < 16; ++r) acc[r] = 0.f;
#pragma unroll
            for (int s = 0; s < 4; ++s) acc = __builtin_amdgcn_mfma_f32_32x32x16_f16(afr[s], bfr[s], acc, 0, 0, 0);
            if (tl + 1 < ntile) {
#pragma unroll
                for (int s = 0; s < 4; ++s) bfr[s] = *(const LAS f16x8*)(cb + (tl + 1) * 4096 + boffs[s]); }
            float t0 = acc[0], t1 = acc[1], t2 = acc[2], t3 = acc[3], t4 = acc[4], t5 = acc[5], t6 = acc[6], t7 = acc[7], t8 = acc[8], t9 = acc[9], t10 = acc[10], t11 = acc[11], t12 = acc[12], t13 = acc[13], t14 = acc[14], t15 = acc[15];
            asm volatile("s_nop 11\n\tv_max_f32 %0, 0, %0\n\tv_max_f32 %1, 0, %1\n\tv_max_f32 %2, 0, %2\n\tv_max_f32 %3, 0, %3\n\tv_max_f32 %4, 0, %4\n\tv_max_f32 %5, 0, %5\n\tv_max_f32 %6, 0, %6\n\tv_max_f32 %7, 0, %7\n\t"
                         "v_max_f32 %8, 0, %8\n\tv_max_f32 %9, 0, %9\n\tv_max_f32 %10, 0, %10\n\tv_max_f32 %11, 0, %11\n\tv_max_f32 %12, 0, %12\n\tv_max_f32 %13, 0, %13\n\tv_max_f32 %14, 0, %14\n\tv_max_f32 %15, 0, %15"
                         : "+v"(t0), "+v"(t1), "+v"(t2), "+v"(t3), "+v"(t4), "+v"(t5), "+v"(t6), "+v"(t7), "+v"(t8), "+v"(t9), "+v"(t10), "+v"(t11), "+v"(t12), "+v"(t13), "+v"(t14), "+v"(t15));
            float sc0 = wv[0] * t0, sc1 = wv[1] * t1;
            sc0 = __builtin_fmaf(wv[2], t2, sc0); sc1 = __builtin_fmaf(wv[3], t3, sc1); sc0 = __builtin_fmaf(wv[4], t4, sc0); sc1 = __builtin_fmaf(wv[5], t5, sc1);
            sc0 = __builtin_fmaf(wv[6], t6, sc0); sc1 = __builtin_fmaf(wv[7], t7, sc1); sc0 = __builtin_fmaf(wv[8], t8, sc0); sc1 = __builtin_fmaf(wv[9], t9, sc1);
            sc0 = __builtin_fmaf(wv[10], t10, sc0); sc1 = __builtin_fmaf(wv[11], t11, sc1); sc0 = __builtin_fmaf(wv[12], t12, sc0); sc1 = __builtin_fmaf(wv[13], t13, sc1);
            sc0 = __builtin_fmaf(wv[14], t14, sc0); sc1 = __builtin_fmaf(wv[15], t15, sc1);
            const float score = sc0 + sc1;
            const int key = kbase + tl * 32 + l31;
            const bool pr = (key <= tq) && (score >= thr);
            const unsigned long long mk = __ballot(pr);
            const unsigned hm = hh ? (unsigned)(mk >> 32) : (unsigned)mk;
            const int rank = cnt + __popc(hm & ((1u << l31) - 1u));
            if (pr && rank < IDX_CAP) { scq[rank] = score; ixq[rank] = (u16)key; }
            cnt += __popc(hm);
        }
        if (cvh) { if (GU_I8 && cj.bf == 3) cv32_finish_i8(cvv, cvg, cj); else if (FFN_F8K && cj.bf == 2) cv32_finish_f8(cvv, cvg, cj); else cv32_finish<FFN_BF16 != 0>(cvv, cvg, cj); young = 4; }
    }
#undef IDX_DMA
    LDS_WAIT(); asm volatile("" ::: "memory");
#pragma unroll 1
    for (int h2 = 0; h2 < 2; ++h2) {
        int n = __builtin_amdgcn_readlane(cnt, 32 * h2); n = n > IDX_CAP ? IDX_CAP : n;
        LAS float* s2 = (LAS float*)(lds + IDX_LDS_SC) + (2 * wave + h2) * IDX_CAP; LAS u16* i2 = (LAS u16*)(lds + IDX_LDS_IX) + (2 * wave + h2) * IDX_CAP;
        u16* out = TK + (size_t)(m0 + 2 * wave + h2) * TOPK;
        if (n <= TOPK || PMODE == 1) {
#pragma unroll
            for (int i = 0; i < 4; ++i) { const int e = lane + 64 * i; out[e] = e < n ? i2[e] : (u16)0; }
        } else list_final(s2, i2, n, lane, out);
    }
}
template <int PMODE = 0> __device__ __forceinline__ void indexer_phase(const Args& a, const f16* IQ, const f16* IK, const float* IW, u16* TK, LAS unsigned char* lds, int bid, int G, int tid, int wave, int lane, int cv0 = 0) {
    CvRun cv; cv.next = PMODE ? CV_LATE : cv0 + bid * NWAVES + wave; cv.stride = G * NWAVES; cv.tick = 0; cv.pend = 0;
    for (int p = bid; p < 512; p += G) {
        const int b = p >> 8, j = p & 255;
        indexer_unit<PMODE>(a, cv, IQ, IK, IW, TK, lds, b, j, tid, wave, lane);
        indexer_unit<PMODE>(a, cv, IQ, IK, IW, TK, lds, b, 511 - j, tid, wave, lane);
    }
    if (PMODE == 0) {
        for (; cv.next < CV32_LATE; cv.next += cv.stride) { CvJob cj; f32x4 v[8]; float gs[8]; cv32_job(a, cv.next, lane, cj); cv32_issue(v, gs, cj, lane, (const float*)(a.ws + WS_CTL + CTL_CMAX)); if (GU_I8 && cj.bf == 3) cv32_finish_i8(v, gs, cj); else if (FFN_F8K && cj.bf == 2) cv32_finish_f8(v, gs, cj); else cv32_finish<FFN_BF16 != 0>(v, gs, cj); }
    }
    __syncthreads();
}

constexpr int SA_WAVE_BYTES = 16384 + 1024;
static_assert(NWAVES * SA_WAVE_BYTES <= SCRATCH_BYTES, "sparse attention LDS");
#define SA_TR16(O0, O1, r, ad) asm volatile( \
    "ds_read_b64_tr_b16 %0, %16 offset:" #O0 "\n\tds_read_b64_tr_b16 %1, %16 offset:" #O1 "\n\tds_read_b64_tr_b16 %2, %17 offset:" #O0 "\n\tds_read_b64_tr_b16 %3, %17 offset:" #O1 "\n\t" \
    "ds_read_b64_tr_b16 %4, %18 offset:" #O0 "\n\tds_read_b64_tr_b16 %5, %18 offset:" #O1 "\n\tds_read_b64_tr_b16 %6, %19 offset:" #O0 "\n\tds_read_b64_tr_b16 %7, %19 offset:" #O1 "\n\t" \
    "ds_read_b64_tr_b16 %8, %20 offset:" #O0 "\n\tds_read_b64_tr_b16 %9, %20 offset:" #O1 "\n\tds_read_b64_tr_b16 %10, %21 offset:" #O0 "\n\tds_read_b64_tr_b16 %11, %21 offset:" #O1 "\n\t" \
    "ds_read_b64_tr_b16 %12, %22 offset:" #O0 "\n\tds_read_b64_tr_b16 %13, %22 offset:" #O1 "\n\tds_read_b64_tr_b16 %14, %23 offset:" #O0 "\n\tds_read_b64_tr_b16 %15, %23 offset:" #O1 "\n\t" \
    "s_waitcnt lgkmcnt(0)" \
    : "=&v"(r[0]), "=&v"(r[1]), "=&v"(r[2]), "=&v"(r[3]), "=&v"(r[4]), "=&v"(r[5]), "=&v"(r[6]), "=&v"(r[7]), "=&v"(r[8]), "=&v"(r[9]), "=&v"(r[10]), "=&v"(r[11]), "=&v"(r[12]), "=&v"(r[13]), "=&v"(r[14]), "=&v"(r[15]) \
    : "v"(ad[0]), "v"(ad[1]), "v"(ad[2]), "v"(ad[3]), "v"(ad[4]), "v"(ad[5]), "v"(ad[6]), "v"(ad[7]) : "memory")

#define SA_GATHER(base_, tp_) do { _Pragma("unroll") for (int i_ = 0; i_ < 16; ++i_) { const int row_ = 4 * i_ + g; const int kid_ = idl[64 * (tp_) + row_]; \
        __builtin_amdgcn_global_load_lds((const unsigned*)((base_) + (size_t)kid_ * (NKV * 2) + 16 * (c ^ (row_ & 15))), (LAS unsigned*)(tile + 1024 * i_), 16, 0, 0); } } while (0)
#define SA_CV_AND_WAIT(GRP) asm volatile("s_waitcnt vmcnt(0)" ::: "memory")

__device__ __forceinline__ void sparse_attn_phase(const Args& a, const f16* Q, const f16* Kb, const f16* Vb, const u16* TK, f16* MIX, LAS unsigned char* lds, LAS unsigned* qctr, int bid, int G, int wave, int lane) {
    LAS unsigned char* tile = lds + wave * SA_WAVE_BYTES; LAS u16* idl = (LAS u16*)(tile + 16384);
    const unsigned tile_addr = (unsigned)(size_t)tile;
    const int c = lane & 15, g = lane >> 4, q4 = c >> 2, p4 = c & 3;
    const float sc2 = 0.08838834764831845f * 1.44269504089f;
    unsigned trad[8];
#pragma unroll
    for (int db = 0; db < 8; ++db) trad[db] = tile_addr + 256 * (4 * g + q4) + 16 * ((2 * db + (p4 >> 1)) ^ (4 * g + q4)) + 8 * (p4 & 1);
    for (;;) {
        int ticket = 0; if (lane == 0) ticket = (int)__hip_atomic_fetch_add(qctr, 1u, __ATOMIC_RELAXED, __HIP_MEMORY_SCOPE_WORKGROUP);
        ticket = __builtin_amdgcn_readfirstlane(ticket);
        const long item = (long)bid + (long)ticket * G;
        if (item >= 8L * SEQ) break;
        const int pair = (int)(item & 7), t = (int)(item >> 3), b = pair >> 2, kvh = pair & 3, m = b * SEQ + t, cnt = (t + 1) < TOPK ? (t + 1) : TOPK;
        { const u32x2 w = *(const u32x2*)(TK + (size_t)m * TOPK + 4 * lane); *(LAS u32x2*)(idl + 4 * lane) = w; }
        f16x8 qf[4];
#pragma unroll
        for (int s = 0; s < 4; ++s) { f16x8 z; for (int e = 0; e < 8; ++e) z[e] = (f16)0.f; qf[s] = c < 4 ? *(const f16x8*)(Q + (size_t)m * NQ + (4 * kvh + c) * 128 + 32 * s + 8 * g) : z; }
        LDS_WAIT(); asm volatile("" ::: "memory");
        f32x4 sacc[16];
#pragma unroll
        for (int i = 0; i < 16; ++i) sacc[i] = (f32x4){0.f, 0.f, 0.f, 0.f};
        const char* kbase = (const char*)(Kb + (size_t)b * SEQ * NKV + kvh * 128);
        const char* vbase = (const char*)(Vb + (size_t)b * SEQ * NKV + kvh * 128);
#define SA_KSTAGE(tp) do { SA_GATHER(kbase, tp); SA_CV_AND_WAIT(tp); \
            _Pragma("unroll") for (int sub = 0; sub < 4; ++sub) _Pragma("unroll") for (int s = 0; s < 4; ++s) { const int row = 16 * sub + c; \
                const f16x8 kf = *(const LAS f16x8*)(tile + 256 * row + 16 * ((4 * s + g) ^ (row & 15))); \
                sacc[4 * (tp) + sub] = __builtin_amdgcn_mfma_f32_16x16x32_f16(kf, qf[s], sacc[4 * (tp) + sub], 0, 0, 0); } \
            LDS_WAIT(); asm volatile("" ::: "memory"); __builtin_amdgcn_sched_barrier(0); } while (0)
#if K_FP8
        long q8[4];
#pragma unroll
        for (int s = 0; s < 4; ++s) { int w0 = __builtin_amdgcn_cvt_pk_fp8_f32((float)qf[s][0], (float)qf[s][1], 0, false); w0 = __builtin_amdgcn_cvt_pk_fp8_f32((float)qf[s][2], (float)qf[s][3], w0, true);
            int w1 = __builtin_amdgcn_cvt_pk_fp8_f32((float)qf[s][4], (float)qf[s][5], 0, false); w1 = __builtin_amdgcn_cvt_pk_fp8_f32((float)qf[s][6], (float)qf[s][7], w1, true);
            q8[s] = (long)(((unsigned long long)(unsigned)w1 << 32) | (unsigned)w0); }
        const char* k8base = (const char*)Kb + (size_t)b * SEQ * NKV + kvh * 128;
#define SA_KSTAGE8(tp) do { _Pragma("unroll") for (int i_ = 0; i_ < 16; ++i_) { const int row_ = 8 * i_ + (lane >> 3); const int kid_ = idl[128 * (tp) + row_]; \
                __builtin_amdgcn_global_load_lds((const unsigned*)(k8base + (size_t)kid_ * NKV + 16 * ((lane & 7) ^ ((row_ >> 1) & 7))), (LAS unsigned*)(tile + 1024 * i_), 16, 0, 0); } \
            asm volatile("s_waitcnt vmcnt(0)" ::: "memory"); \
            _Pragma("unroll") for (int sub = 0; sub < 8; ++sub) _Pragma("unroll") for (int s = 0; s < 4; ++s) { const int row = 16 * sub + c; \
                const long kf = *(const LAS long*)(tile + 128 * row + 16 * ((2 * s + (g >> 1)) ^ ((row >> 1) & 7)) + 8 * (g & 1)); \
                sacc[8 * (tp) + sub] = __builtin_amdgcn_mfma_f32_16x16x32_fp8_fp8(kf, q8[s], sacc[8 * (tp) + sub], 0, 0, 0); } \
            LDS_WAIT(); asm volatile("" ::: "memory"); __builtin_amdgcn_sched_barrier(0); } while (0)
        SA_KSTAGE8(0); SA_KSTAGE8(1);
#undef SA_KSTAGE8
#else
        SA_KSTAGE(0); SA_KSTAGE(1); SA_KSTAGE(2); SA_KSTAGE(3);
#endif
        float mx = -INFINITY;
#pragma unroll
        for (int T = 0; T < 16; ++T)
#pragma unroll
            for (int j = 0; j < 4; ++j) { const float s = (16 * T + 4 * g + j) < cnt ? sacc[T][j] * sc2 : -INFINITY; sacc[T][j] = s; mx = fmaxf(mx, s); }
        mx = fmaxf(mx, __shfl_xor(mx, 16)); mx = fmaxf(mx, __shfl_xor(mx, 32));
        float sum = 0.f;
#pragma unroll
        for (int T = 0; T < 16; ++T)
#pragma unroll
            for (int j = 0; j < 4; ++j) { const float p = __builtin_amdgcn_exp2f(sacc[T][j] - mx); sacc[T][j] = p; sum += p; }
        sum += __shfl_xor(sum, 16); sum += __shfl_xor(sum, 32);
        f16x8 pf[8];
#pragma unroll
        for (int u = 0; u < 8; ++u) { f16x8 v;
#pragma unroll
            for (int j = 0; j < 4; ++j) { v[j] = (f16)sacc[2 * u][j]; v[4 + j] = (f16)sacc[2 * u + 1][j]; }
            pf[u] = v; }
        f32x4 oacc[8];
#pragma unroll
        for (int i = 0; i < 8; ++i) oacc[i] = (f32x4){0.f, 0.f, 0.f, 0.f};
#define SA_PV(r, u) do { _Pragma("unroll") for (int db = 0; db < 8; ++db) { f16x8 vf; vf[0] = r[2 * db][0]; vf[1] = r[2 * db][1]; vf[2] = r[2 * db][2]; vf[3] = r[2 * db][3]; \
                vf[4] = r[2 * db + 1][0]; vf[5] = r[2 * db + 1][1]; vf[6] = r[2 * db + 1][2]; vf[7] = r[2 * db + 1][3]; \
                oacc[db] = __builtin_amdgcn_mfma_f32_16x16x32_f16(vf, pf[u], oacc[db], 0, 0, 0); } } while (0)
#define SA_VSTAGE(tp) do { SA_GATHER(vbase, tp); SA_CV_AND_WAIT(4 + (tp)); \
            { f16x4 r0[16]; SA_TR16(0, 4096, r0, trad); __builtin_amdgcn_sched_barrier(0); SA_PV(r0, 2 * (tp)); } \
            { f16x4 r1[16]; SA_TR16(8192, 12288, r1, trad); __builtin_amdgcn_sched_barrier(0); SA_PV(r1, 2 * (tp) + 1); } \
            LDS_WAIT(); asm volatile("" ::: "memory"); __builtin_amdgcn_sched_barrier(0); } while (0)
#if V_FP8
        long p8[8];
#pragma unroll
        for (int u = 0; u < 8; ++u) { int w0 = __builtin_amdgcn_cvt_pk_fp8_f32(sacc[2 * u][0], sacc[2 * u][1], 0, false); w0 = __builtin_amdgcn_cvt_pk_fp8_f32(sacc[2 * u][2], sacc[2 * u][3], w0, true);
            int w1 = __builtin_amdgcn_cvt_pk_fp8_f32(sacc[2 * u + 1][0], sacc[2 * u + 1][1], 0, false); w1 = __builtin_amdgcn_cvt_pk_fp8_f32(sacc[2 * u + 1][2], sacc[2 * u + 1][3], w1, true);
            p8[u] = (long)(((unsigned long long)(unsigned)w1 << 32) | (unsigned)w0); }
        const char* v8base = (const char*)Vb + (size_t)b * SEQ * NKV + kvh * 128;
        unsigned trad8[8];
        { const int rr = c >> 1, cc = c & 1, rowl = rr < 4 ? 4 * g + rr : 16 + 4 * g + (rr - 4), fl = ((rowl >> 1) & 3) | (((rowl >> 4) & 1) << 2);
#pragma unroll
          for (int db = 0; db < 8; ++db) trad8[db] = tile_addr + 128 * rowl + 16 * (db ^ fl) + 8 * cc; }
#define SA_TR8(OFF, r, ad) asm volatile( \
            "ds_read_b64_tr_b8 %0, %8 offset:" #OFF "\n\tds_read_b64_tr_b8 %1, %9 offset:" #OFF "\n\tds_read_b64_tr_b8 %2, %10 offset:" #OFF "\n\tds_read_b64_tr_b8 %3, %11 offset:" #OFF "\n\t" \
            "ds_read_b64_tr_b8 %4, %12 offset:" #OFF "\n\tds_read_b64_tr_b8 %5, %13 offset:" #OFF "\n\tds_read_b64_tr_b8 %6, %14 offset:" #OFF "\n\tds_read_b64_tr_b8 %7, %15 offset:" #OFF "\n\t" \
            "s_waitcnt lgkmcnt(0)" \
            : "=&v"(r[0]), "=&v"(r[1]), "=&v"(r[2]), "=&v"(r[3]), "=&v"(r[4]), "=&v"(r[5]), "=&v"(r[6]), "=&v"(r[7]) \
            : "v"(ad[0]), "v"(ad[1]), "v"(ad[2]), "v"(ad[3]), "v"(ad[4]), "v"(ad[5]), "v"(ad[6]), "v"(ad[7]) : "memory")
#define SA_PV8(OFF, u) do { long r8[8]; SA_TR8(OFF, r8, trad8); __builtin_amdgcn_sched_barrier(0); \
            _Pragma("unroll") for (int db = 0; db < 8; ++db) oacc[db] = __builtin_amdgcn_mfma_f32_16x16x32_fp8_fp8(r8[db], p8[u], oacc[db], 0, 0, 0); } while (0)
#define SA_VSTAGE8(tp) do { _Pragma("unroll") for (int i_ = 0; i_ < 16; ++i_) { const int row_ = 8 * i_ + (lane >> 3); const int kid_ = idl[128 * (tp) + row_]; \
                __builtin_amdgcn_global_load_lds((const unsigned*)(v8base + (size_t)kid_ * NKV + 16 * ((lane & 7) ^ (((row_ >> 1) & 3) | (((row_ >> 4) & 1) << 2)))), (LAS unsigned*)(tile + 1024 * i_), 16, 0, 0); } \
            asm volatile("s_waitcnt vmcnt(0)" ::: "memory"); \
            SA_PV8(0, 4 * (tp)); SA_PV8(4096, 4 * (tp) + 1); SA_PV8(8192, 4 * (tp) + 2); SA_PV8(12288, 4 * (tp) + 3); \
            LDS_WAIT(); asm volatile("" ::: "memory"); __builtin_amdgcn_sched_barrier(0); } while (0)
        SA_VSTAGE8(0); SA_VSTAGE8(1);
#undef SA_VSTAGE8
#undef SA_PV8
#undef SA_TR8
#else
        SA_VSTAGE(0); SA_VSTAGE(1); SA_VSTAGE(2); SA_VSTAGE(3);
#endif
        const float inv = 1.0f / sum;
        if (c < 4) {
#if OUT_FP8
            unsigned char* op = (unsigned char*)MIX + (size_t)m * MIXB + (OUT_I8P ? 2048 : 0) + (4 * kvh + c) * 128 + 4 * g;
            const float inv16 = inv * 16.0f;
#pragma unroll
            for (int db = 0; db < 8; ++db) { int w = __builtin_amdgcn_cvt_pk_fp8_f32(oacc[db][0] * inv16, oacc[db][1] * inv16, 0, false); w = __builtin_amdgcn_cvt_pk_fp8_f32(oacc[db][2] * inv16, oacc[db][3] * inv16, w, true); *(unsigned*)(op + 16 * db) = (unsigned)w; }
#else
            f16* op = MIX + (size_t)m * DM + (4 * kvh + c) * 128 + 4 * g;
#pragma unroll
            for (int db = 0; db < 8; ++db) { u32x2 w; w.x = pk2t<FFN_BF16 != 0>(oacc[db][0] * inv, oacc[db][1] * inv); w.y = pk2t<FFN_BF16 != 0>(oacc[db][2] * inv, oacc[db][3] * inv); *(u32x2*)(op + 16 * db) = w; }
#endif
        }
    }
#undef SA_KSTAGE
#undef SA_VSTAGE
#undef SA_PV
}

__device__ __forceinline__ void rows2048_quant(const f16* src, unsigned char* dst, int dstride, const float* rmax, int nrows, int gw, int NGW, int lane) {
    for (int m = gw; m < nrows; m += NGW) {
        const float s = 127.0f * __builtin_amdgcn_rcpf(fmaxf(rmax[m], 1e-30f));
        const u32x4* xi = (const u32x4*)(src + (size_t)m * 2048) + lane; u32x2* o = (u32x2*)(dst + (size_t)m * dstride) + lane;
        u32x4 xv[4];
#pragma unroll
        for (int j = 0; j < 4; ++j) xv[j] = xi[64 * j];
        asm volatile("" ::: "memory");
#pragma unroll
        for (int j = 0; j < 4; ++j) { const u32x4 w = xv[j];
            f32x4 a = {__builtin_bit_cast(float, w.x << 16), __builtin_bit_cast(float, w.x & 0xffff0000u), __builtin_bit_cast(float, w.y << 16), __builtin_bit_cast(float, w.y & 0xffff0000u)};
            f32x4 b = {__builtin_bit_cast(float, w.z << 16), __builtin_bit_cast(float, w.z & 0xffff0000u), __builtin_bit_cast(float, w.w << 16), __builtin_bit_cast(float, w.w & 0xffff0000u)};
#pragma unroll
            for (int e = 0; e < 4; ++e) { a[e] = __builtin_amdgcn_fmed3f(a[e] * s, -127.f, 127.f); b[e] = __builtin_amdgcn_fmed3f(b[e] * s, -127.f, 127.f); }
            u32x2 q; q.x = q8x4(a); q.y = q8x4(b); o[64 * j] = q; }
    }
}

__device__ __forceinline__ void x1_quant_phase(const f16* x1, unsigned char* xq, const float* rmax, int vcu, int G, int wave, int lane) {
    const int gw = vcu * NWAVES + wave, NGW = G * NWAVES;
    for (int m = gw; m < M; m += NGW) {
        const float s = 127.0f * __builtin_amdgcn_rcpf(fmaxf(rmax[m], 1e-30f));
        const u32x4* xi = (const u32x4*)(x1 + (size_t)m * DM) + lane; u32x2* o = (u32x2*)(xq + (size_t)m * DM) + lane;
        u32x4 xv[8];
#pragma unroll
        for (int j = 0; j < 8; ++j) xv[j] = xi[64 * j];
        asm volatile("" ::: "memory");
#pragma unroll
        for (int j = 0; j < 8; ++j) { const u32x4 w = xv[j];
            f32x4 a = {__builtin_bit_cast(float, w.x << 16), __builtin_bit_cast(float, w.x & 0xffff0000u), __builtin_bit_cast(float, w.y << 16), __builtin_bit_cast(float, w.y & 0xffff0000u)};
            f32x4 b = {__builtin_bit_cast(float, w.z << 16), __builtin_bit_cast(float, w.z & 0xffff0000u), __builtin_bit_cast(float, w.w << 16), __builtin_bit_cast(float, w.w & 0xffff0000u)};
#pragma unroll
            for (int e = 0; e < 4; ++e) { a[e] = __builtin_amdgcn_fmed3f(a[e] * s, -127.f, 127.f); b[e] = __builtin_amdgcn_fmed3f(b[e] * s, -127.f, 127.f); }
            u32x2 q; q.x = q8x4(a); q.y = q8x4(b); o[64 * j] = q; }
    }
}

__device__ __forceinline__ void final_norm_phase(const f16* x2, float* out, const float* ss3, const float* gf, int vcu, int G, int wave, int lane) {
    const int gw = vcu * NWAVES + wave, NGW = G * NWAVES;
    for (int m = gw; m < M; m += NGW) {
        const float r = 1.0f / sqrtf(ss3[m] * (1.0f / DM) + EPS);
        const f16x8* xi = (const f16x8*)(x2 + (size_t)m * DM) + lane; f32x4* o = (f32x4*)(out + (size_t)m * DM) + 2 * lane; const f32x4* gp = (const f32x4*)gf + 2 * lane;
        f16x8 xv[8]; f32x4 gv[8][2];
#pragma unroll
        for (int j = 0; j < 8; ++j) { xv[j] = xi[64 * j]; gv[j][0] = gp[128 * j]; gv[j][1] = gp[128 * j + 1]; }
        asm volatile("" ::: "memory");
#pragma unroll
        for (int j = 0; j < 8; ++j) { const f16x8 v = xv[j];
            o[128 * j] = (f32x4){(float)v[0], (float)v[1], (float)v[2], (float)v[3]} * r * gv[j][0];
            o[128 * j + 1] = (f32x4){(float)v[4], (float)v[5], (float)v[6], (float)v[7]} * r * gv[j][1]; }
    }
}

__global__ void __launch_bounds__(NWAVES * 64, 2) fwd(Args args) {
    extern __shared__ __attribute__((aligned(16))) unsigned char lds_raw[];
    LAS unsigned char* lds = (LAS unsigned char*)lds_raw;
    volatile LAS unsigned* MISC = (volatile LAS unsigned*)(lds + LDSCTL_OFF + 320);
    const int wave = __builtin_amdgcn_readfirstlane(threadIdx.x >> 6);
#define FRESH_TID() const int tid = fresh_tid(wave); const int lane = tid & 63
    const int G = gridDim.x, bid = blockIdx.x, vcu = (G % 8 == 0) ? (bid % 8) * (G / 8) + bid / 8 : bid;
    unsigned char* ws = args.ws;
    gu32* ctl = (gu32*)(ws + WS_CTL);
    for (int u = fresh_tid(wave); u < (LDS_BYTES - LDSCTL_OFF) / 4; u += NWAVES * 64) ((LAS unsigned*)(lds + LDSCTL_OFF))[u] = 0u;
    __syncthreads();
    XcdBarrier bar; bar.bar = (unsigned*)(ctl + CW_BAR); bar.x = 0; bar.st = nullptr; bar.wave = wave;
    if (MK_N_LAUNCHES == 1) bar = xcd_barrier_post((unsigned*)(ctl + CW_BAR), MISC + 8, wave);
    const int lo = args.ph_lo, hi = args.ph_hi;
#define IN(k) (lo <= (k) && (k) < hi)
#define BOTH(k) (IN(k) && IN((k) + 1))
#define GRID_BAR() do { if (MK_N_LAUNCHES == 1) xcd_barrier(bar); } while (0)
    f16* XH = (f16*)(ws + WS_XH); f16* Qb = (f16*)(ws + WS_Q); f16* Kb = (f16*)(ws + WS_K); f16* Vb = (f16*)(ws + WS_V); f16* IQ = (f16*)(ws + WS_IQ); f16* IK = (f16*)(ws + WS_IK);
    f16* Ub = (f16*)(ws + WS_U); f16* PD = (f16*)(ws + WS_PD); f16* MIX = (f16*)(ws + WS_MIX); f16* Ab = (f16*)(ws + WS_A); float* IW = (float*)(ws + WS_IW); u16* TK = (u16*)(ws + WS_TOPK);
    float* SS2 = (float*)(ws + WS_CTL + CTL_SS2); float* SS3 = (float*)(ws + WS_CTL + CTL_SS3);

    if (IN(0)) { FRESH_TID(); p0_prologue(args, lds, vcu, G, wave, lane);
        if (U_I8) { GRID_BAR(); p0_convert(args, vcu, G, wave, lane); }
        if (BOTH(0)) GRID_BAR(); }
    if (IN(1)) {
        if (QKV_FP8) {
            if (QKV_I8) { pg8::Gemm g{(const char*)(ws + WS_X8I), (const char*)(ws + WS_W8), DM / 2, DM / 2, DM / 2, 0, 0x7f7f7f7fu, (const float*)(ws + WS_CTL + CTL_CMAXQ)}; pg8::StaticOrder S; S.init(M / 256, 12, G, bid);
              EpiInT<1> E{(const float*)(ws + WS_R1X), (const float*)(ws + WS_COSA), (const float*)(ws + WS_SINA), (const float*)(ws + WS_COSI), (const float*)(ws + WS_SINI), Qb, Kb, Vb, IQ, IK, Ub, IW, 0, 1.0f};
              pg8::gemm_phase<EpiInT<1>, false, true, false, false, 0, true>(lds, g, S, E, wave); }
            else { pg8::Gemm g{(const char*)(ws + WS_X8), (const char*)(ws + WS_W8), DM / 2, DM / 2, DM / 2, 0}; pg8::StaticOrder S; S.init(M / 256, 12, G, bid);
              EpiInT<1> E{(const float*)(ws + WS_R1), (const float*)(ws + WS_COSA), (const float*)(ws + WS_SINA), (const float*)(ws + WS_COSI), (const float*)(ws + WS_SINI), Qb, Kb, Vb, IQ, IK, Ub, IW, 0, 1.0f / 64.0f};
              pg8::gemm_phase<EpiInT<1>, false, true, false, false, pg8::F8_ALL>(lds, g, S, E, wave); }
            if (U_I8) { pg8::Gemm g{(const char*)(ws + WS_X8I), (const char*)(ws + WS_W8I), DM / 2, DM / 2, DM / 2, 0}; pg8::StaticOrder S; S.init(M / 256, 8, G, bid);
              EpiU8 E{(const float*)(ws + WS_R1), (const float*)(ws + WS_XMAX), (const float*)(ws + WS_CTL + CTL_CMAXU), Ub};
              pg8::gemm_phase<EpiU8, false, true, false, false, 0, true>(lds, g, S, E, wave); }
            { pg8::Gemm g{(const char*)XH, (const char*)(ws + WS_WIN) + (size_t)3072 * DM * 2, DM, DM, DM, 0}; pg8::StaticOrder S; S.init(M / 256, U_I8 ? 4 : 12, G, bid);
              EpiIn E{(const float*)(ws + WS_R1), (const float*)(ws + WS_COSA), (const float*)(ws + WS_SINA), (const float*)(ws + WS_COSI), (const float*)(ws + WS_SINI), Qb, Kb, Vb, IQ, IK, Ub, IW, 12, 1.0f};
              pg8::gemm_phase<EpiIn>(lds, g, S, E, wave); }
        } else {
        pg8::Gemm g{(const char*)XH, (const char*)(ws + WS_WIN), DM, DM, DM, 0}; pg8::StaticOrder S; S.init(M / 256, 24, G, bid);
        EpiIn E{(const float*)(ws + WS_R1), (const float*)(ws + WS_COSA), (const float*)(ws + WS_SINA), (const float*)(ws + WS_COSI), (const float*)(ws + WS_SINI), Qb, Kb, Vb, IQ, IK, Ub, IW, 0, 1.0f};
        pg8::gemm_phase<EpiIn>(lds, g, S, E, wave);
        }
        if (BOTH(1)) GRID_BAR();
    }
    if (IN(2)) {
        FRESH_TID();
        const bool split = (G % 4 == 0) && G >= 64;
        if (!split || (bid & 3) == 0) {
            pg8::Gemm g{(const char*)XH, (const char*)(ws + WS_WIN), DM, DM, DM, 0}; pg8::StaticOrder S; S.init(M / 256, 25, split ? G / 4 : G, split ? bid >> 2 : bid, 24);
            EpiIn E{(const float*)(ws + WS_R1), (const float*)(ws + WS_COSA), (const float*)(ws + WS_SINA), (const float*)(ws + WS_COSI), (const float*)(ws + WS_SINI), Qb, Kb, Vb, IQ, IK, Ub, IW, 0, 1.0f};
            pg8::gemm_phase<EpiIn, false, true, false, true>(lds, g, S, E, wave);
        }
        const size_t npd = (size_t)M * 256, cut = npd / 16 * 15;
        f16* pdd = OUT_I8P ? (f16*)(ws + WS_DIFFB) : POOL_FOLD ? MIX : PD;
        float* dmx = OUT_I8P ? (float*)(ws + WS_CTL + CTL_DMAX) : nullptr;
        if (!split) { if (OUT_I8P) pool_diff_rows_i8(Ub, (unsigned char*)MIX, dmx, bid * NWAVES + wave, G * NWAVES, lane, 0, M); else pool_diff_phase<POOL_FOLD != 0>(Ub, pdd, bid, G, tid, 0, (size_t)M * 256, dmx); }
        else if ((bid & 3) != 0) { const int vi = (bid >> 2) * 3 + (bid & 3) - 1, nv = (G / 4) * 3;
            if (OUT_I8P) pool_diff_rows_i8(Ub, (unsigned char*)MIX, dmx, vi * NWAVES + wave, nv * NWAVES, lane, 0, M / 16 * 15);
            else pool_diff_phase<POOL_FOLD != 0>(Ub, pdd, vi, nv, tid, 0, cut, dmx);
            for (int it = vi * NWAVES + wave; it < P2_CV_ROUNDS * nv * NWAVES; it += nv * NWAVES) { CvJob cj; f32x4 v[8]; float gs[8]; cv32_job(args, it, lane, cj); cv32_issue(v, gs, cj, lane, (const float*)(ws + WS_CTL + CTL_CMAX));
                if (GU_I8 && cj.bf == 3) cv32_finish_i8(v, gs, cj); else if (FFN_F8K && cj.bf == 2) cv32_finish_f8(v, gs, cj); else cv32_finish<FFN_BF16 != 0>(v, gs, cj); }
        }
        else if (OUT_I8P) pool_diff_rows_i8(Ub, (unsigned char*)MIX, dmx, (bid >> 2) * NWAVES + wave, (G / 4) * NWAVES, lane, M / 16 * 15, M);
        else pool_diff_phase<POOL_FOLD != 0>(Ub, pdd, bid >> 2, G / 4, tid, cut, npd, dmx);
        if (BOTH(2)) GRID_BAR();
    }
    if (IN(3)) {
        FRESH_TID();
        indexer_phase(args, IQ, IK, IW, TK, lds, bid, G, tid, wave, lane, P2_CV_ROUNDS * (((G % 4 == 0) && G >= 64) ? (G / 4) * 3 * NWAVES : 0));
        if (PROBE_REP == 21) indexer_phase(args, IQ, IK, IW, TK, lds, bid, G, tid, wave, lane);
        if (PROBE_REP == 23) indexer_phase<1>(args, IQ, IK, IW, (u16*)(ws + WS_MIX), lds, bid, G, tid, wave, lane);
        if (PROBE_REP == 24) indexer_phase<2>(args, IQ, IK, IW, (u16*)(ws + WS_MIX), lds, bid, G, tid, wave, lane);
        if (PROBE_REP == 25) indexer_phase<3>(args, IQ, IK, IW, (u16*)(ws + WS_MIX), lds, bid, G, tid, wave, lane);
        if (BOTH(3)) GRID_BAR();
    }
    if (IN(4)) {
        FRESH_TID();
        if (POOL_FOLD) {
            pg8::Gemm g{(const char*)(ws + WS_WORAW), (const char*)(ws + WS_WPOOL), 2048, 512, 512, 1}; pg8::StaticOrder S; S.init(DM / 256, 8, G, bid);
            EpiPool E{nullptr, OUT_I8P ? (f16*)(ws + WS_WPB) : (f16*)(ws + WS_WOUT), OUT_I8P ? (float*)(ws + WS_CTL + CTL_WPMAX) : nullptr}; pg8::gemm_phase<EpiPool, FFN_BF16 != 0>(lds, g, S, E, wave);
            if (OUT_I8P && bid < S.nwg) {
                if (tid == 0) { __builtin_amdgcn_fence(__ATOMIC_RELEASE, "agent"); __hip_atomic_fetch_add((unsigned*)(ctl + CW_WPC), (unsigned)((S.nwg - bid + G - 1) / G), __ATOMIC_RELAXED, __HIP_MEMORY_SCOPE_AGENT); } }
        } else
        { pg8::Gemm g{(const char*)PD, (const char*)(ws + WS_WPOOL), NU, 512, 512, 1}; pg8::StaticOrder S; S.init(M / 256, 8, G, bid);
          EpiPool E{args.in[4], MIX, nullptr}; pg8::gemm_phase<EpiPool>(lds, g, S, E, wave); if (PROBE_REP == 30) pg8::gemm_phase<EpiPool>(lds, g, S, E, wave); }
        LAS unsigned* qctr = (LAS unsigned*)(lds + LDSCTL_OFF + 320 + 64);
        if (tid == 0) *qctr = 0u;
        __syncthreads();
        sparse_attn_phase(args, Qb, Kb, Vb, TK, MIX, lds, qctr, bid, G, wave, lane);
        if (PROBE_REP == 31) { __syncthreads(); if (tid == 0) *qctr = 0u; __syncthreads(); sparse_attn_phase(args, Qb, Kb, Vb, TK, MIX, lds, qctr, bid, G, wave, lane); }
        if (OUT_I8P) {
            __syncthreads();
            if (tid == 0) { unsigned sp = 0; while (__hip_atomic_load((unsigned*)(ctl + CW_WPC), __ATOMIC_RELAXED, __HIP_MEMORY_SCOPE_AGENT) < 128u && ++sp < (1u << 22)) __builtin_amdgcn_s_sleep(2);
                __builtin_amdgcn_fence(__ATOMIC_ACQUIRE, "agent"); }
            __syncthreads();
            rows2048_quant((const f16*)(ws + WS_WPB), ws + WS_WOUT, MIXB, (const float*)(ws + WS_CTL + CTL_WPMAX), DM, vcu * NWAVES + wave, G * NWAVES, lane);
        }
        if (BOTH(4)) GRID_BAR();
    }
    if (IN(5)) {
        pg8::Gemm g{(const char*)MIX, (const char*)(ws + WS_WOUT), MIXB / 2, MIXB / 2, MIXB / 2, 0, OUT_FP8 ? 0x7a7a7a7au : 0x7f7f7f7fu, OUT_I8P ? (const float*)(ws + WS_CTL + CTL_WPMAX) : nullptr, OUT_I8P ? (const float*)(ws + WS_CTL + CTL_DMAX) : nullptr}; pg8::StaticOrder S; S.init(M / 256, DM / 256, G, bid);
        EpiRes<false, FFN_BF16 != 0, GU_I8 ? 3 : FFN_F8K ? 1 : 0> E{XH, SS2, GU_I8 ? ws + WS_CTL + CTL_RMAX : ws + WS_XA};
        if (OUT_I8P) pg8::gemm_phase<EpiRes<false, FFN_BF16 != 0, GU_I8 ? 3 : FFN_F8K ? 1 : 0>, FFN_BF16 != 0, true, false, false, pg8::F8_ALL, false, 16>(lds, g, S, E, wave);
        else pg8::gemm_phase<EpiRes<false, FFN_BF16 != 0, GU_I8 ? 3 : FFN_F8K ? 1 : 0>, FFN_BF16 != 0, true, false, false, OUT_FP8 ? 16 : 0>(lds, g, S, E, wave);
        if (BOTH(5)) GRID_BAR();
    }
    if (IN(6)) {
        if (GU_I8) { FRESH_TID(); x1_quant_phase(XH, ws + WS_XA, (const float*)(ws + WS_CTL + CTL_RMAX), vcu, G, wave, lane); GRID_BAR(); }
        constexpr int GUK = GU_I8 ? DM / 2 : XAB / 2;
        pg8::Gemm g{(FFN_F8K || GU_I8) ? (const char*)(ws + WS_XA) : (const char*)XH, (const char*)(ws + WS_WGU), GUK, GUK, GUK, 0, FFN_F8K ? 0x7b7b7b7bu : 0x7f7f7f7fu}; pg8::StaticOrder S; S.init(M / 256, NGU / 256, G, bid);
        constexpr int F8T6 = GU_I8 ? 0 : KF6 / 128; constexpr bool I86 = GU_I8 != 0;
        EpiGU E{SS2, Ab, (const float*)(ws + WS_CTL + CTL_RMAX), (const float*)(ws + WS_CTL + CTL_CMAX)};
        const int nfull = S.nwg / G, rest = S.nwg - nfull * G;
        if (rest > 0 && 2 * rest <= G) {
            S.imax = nfull; pg8::gemm_phase<EpiGU, FFN_BF16 != 0, true, false, false, F8T6, I86>(lds, g, S, E, wave);
            pg8::StaticOrder S2; S2.init(M / 256, NGU / 256, G, bid); S2.hbase = nfull * G;
            if (bid < 2 * rest) pg8::gemm_phase<EpiGU, FFN_BF16 != 0, true, true, false, F8T6, I86>(lds, g, S2, E, wave);
        } else pg8::gemm_phase<EpiGU, FFN_BF16 != 0, true, false, false, F8T6, I86>(lds, g, S, E, wave);
        if (BOTH(6)) GRID_BAR();
    }
    if (IN(7)) {
        pg8::Gemm g{(const char*)Ab, (const char*)(ws + WS_WDN), ABB / 2, ABB / 2, ABB / 2, 0, FFN_F8K ? 0x7a7a7a7au : 0x7f7f7f7fu}; pg8::StaticOrder S; S.init(M / 256, DM / 256, G, bid);
        EpiRes<FFN_BF16 != 0, false, (FFN_F8K && !GU_I8) ? 2 : 0> E{XH, SS3, ws + WS_XA};
        pg8::gemm_phase<EpiRes<FFN_BF16 != 0, false, (FFN_F8K && !GU_I8) ? 2 : 0>, FFN_BF16 != 0, true, false, false, (KF7 == DFF ? pg8::F8_ALL : KF7 / 128)>(lds, g, S, E, wave);
        if (BOTH(7)) GRID_BAR();
    }
    if (IN(8)) { FRESH_TID(); final_norm_phase((const f16*)XH, args.out, SS3, args.in[10], vcu, G, wave, lane); }
#undef FRESH_TID
#undef IN
#undef BOTH
#undef GRID_BAR
}

extern "C" void kernel_launch(void* const* d_in, const int* in_sizes, int n_in, void* d_out, int out_size, void* d_ws, size_t ws_size, hipStream_t stream) {
    static int grid = 0;
    if (grid == 0) {
        if (n_in != 11 || in_sizes[0] != M * DM || out_size != M * DM || ws_size < WS_END) { fprintf(stderr, "kernel_launch: unexpected shapes (n_in %d, in0 %d, out %d, ws %zu)\n", n_in, n_in > 0 ? in_sizes[0] : -1, out_size, ws_size); grid = -1; return; }
        int dev = 0, cus = 0, per_cu = 0;
        if (hipGetDevice(&dev) != hipSuccess || hipDeviceGetAttribute(&cus, hipDeviceAttributeMultiprocessorCount, dev) != hipSuccess) { grid = -1; return; }
        if (hipFuncSetAttribute((const void*)fwd, hipFuncAttributeMaxDynamicSharedMemorySize, LDS_BYTES) != hipSuccess) { fprintf(stderr, "kernel_launch: hipFuncSetAttribute failed\n"); grid = -1; return; }
        if (hipOccupancyMaxActiveBlocksPerMultiprocessor(&per_cu, (const void*)fwd, NWAVES * 64, LDS_BYTES) != hipSuccess || per_cu < 1) { fprintf(stderr, "kernel_launch: occupancy query says %d blocks per CU\n", per_cu); per_cu = 1; }
        (void)hipGetLastError();
        grid = cus;
    }
    if (grid < 0) return;
    (void)hipMemsetAsync((char*)d_ws + WS_CTL, 0, CTL_ZERO_BYTES, stream);
    Args a{};
    for (int i = 0; i < 11; ++i) a.in[i] = (const float*)d_in[i];
    a.out = (float*)d_out; a.ws = (unsigned char*)d_ws;
    for (int i = 0; i < 16; ++i) a.invfA[i] = (float)pow(500000.0, -(double)i / 16.0);
    for (int i = 0; i < 8; ++i) a.invfI[i] = (float)pow(500000.0, -(double)i / 8.0);
    constexpr int NPH = 9;
    if (MK_N_LAUNCHES == 1) { a.ph_lo = 0; a.ph_hi = NPH; a.li = 0; hipLaunchKernelGGL(fwd, dim3(grid), dim3(NWAVES * 64), LDS_BYTES, stream, a); }
    else for (int p = 0; p < NPH; ++p) { a.ph_lo = p; a.ph_hi = p + 1; a.li = p; hipLaunchKernelGGL(fwd, dim3(grid), dim3(NWAVES * 64), LDS_BYTES, stream, a); }
}
```

```cpp
#include <hip/hip_runtime.h>
#include <cstdio>
#include <cstdint>
#include <cmath>

#ifndef MK_N_LAUNCHES
#define MK_N_LAUNCHES 1
#endif

#ifndef PROBE_REP
#define PROBE_REP -1
#endif
#ifndef K_FP8
#define K_FP8 1
#endif
#ifndef V_FP8
#define V_FP8 1
#endif
#ifndef QKV_FP8
#define QKV_FP8 1
#endif
#ifndef OUT_FP8
#define OUT_FP8 1
#endif
#ifndef FFN_F8K
#define FFN_F8K 1
#endif
#ifndef POOL_FOLD
#define POOL_FOLD 1
#endif
#ifndef P2_CV_ROUNDS
#define P2_CV_ROUNDS 8
#endif
#ifndef GU_I8
#define GU_I8 1
#endif
#ifndef U_I8
#define U_I8 1
#endif
#ifndef QKV_I8
#define QKV_I8 1
#endif
#ifndef OUT_I8P
#define OUT_I8P 1
#endif
#ifndef CMF_SPLIT
#define CMF_SPLIT 1
#endif
#ifndef FFN_BF16
#define FFN_BF16 1
#endif
#define LAS __attribute__((address_space(3)))
#define GAS __attribute__((address_space(1)))
typedef _Float16 f16;
typedef _Float16 f16x8 __attribute__((ext_vector_type(8)));
typedef _Float16 f16x4 __attribute__((ext_vector_type(4)));
typedef _Float16 f16x2 __attribute__((ext_vector_type(2)));
typedef float f32x4 __attribute__((ext_vector_type(4)));
typedef float f32x2 __attribute__((ext_vector_type(2)));
typedef float f32x16 __attribute__((ext_vector_type(16)));
typedef unsigned u32x4 __attribute__((ext_vector_type(4)));
typedef unsigned u32x2 __attribute__((ext_vector_type(2)));
typedef unsigned short u16;
typedef short bf16x8 __attribute__((ext_vector_type(8)));
typedef int i32x8 __attribute__((ext_vector_type(8)));
typedef int i32x4 __attribute__((ext_vector_type(4)));
typedef GAS unsigned gu32;

constexpr int SEQ = 8192, DM = 4096, M = 16384;
constexpr int NQ = 2048, NKV = 512, NIQ = 1024, NIK = 64, NIW = 16, NU = 2048, IN_W = 6224;
constexpr int NIN_T = 6400;
constexpr int DFF = 11008, NGU = 2 * DFF;
constexpr int TOPK = 256;
constexpr float EPS = 1e-6f;
constexpr int NWAVES = 8;

constexpr size_t MiB = 1u << 20;
constexpr size_t WS_CTL = 0, CTL_ZERO_BYTES = 1 * MiB;
constexpr int CW_TMO = 0, CW_CODE = 1, CW_BAR = 4096;
constexpr size_t CTL_CMAXQ = 912 * 1024;
constexpr size_t CTL_DMAX = 384 * 1024, CTL_WPMAX = 448 * 1024;
constexpr size_t CTL_CMAXU = 896 * 1024;
constexpr size_t CTL_CMAX = 640 * 1024, CTL_RMAX = 768 * 1024;
constexpr size_t CTL_SS2 = 256 * 1024, CTL_SS3 = 512 * 1024;
constexpr size_t WS_R1 = 1 * MiB;
constexpr size_t WS_COSA = 2 * MiB, WS_SINA = 2 * MiB + 512 * 1024, WS_COSI = 3 * MiB, WS_SINI = 3 * MiB + 256 * 1024;
constexpr size_t WS_IW = 4 * MiB, WS_IK = 5 * MiB, WS_TOPK = 8 * MiB;
constexpr size_t WS_WIN = 16 * MiB, WS_WOUT = 66 * MiB, WS_WGU = 98 * MiB, WS_WDN = 270 * MiB, WS_WPOOL = 356 * MiB;
constexpr size_t WS_XH = 360 * MiB, WS_Q = 488 * MiB, WS_K = 552 * MiB, WS_V = 568 * MiB, WS_IQ = 584 * MiB, WS_U = 616 * MiB, WS_PD = 680 * MiB, WS_MIX = 744 * MiB;
constexpr size_t WS_X8 = 744 * MiB, WS_W8 = 808 * MiB;
constexpr size_t WS_A = 488 * MiB;
constexpr size_t WS_XA = 872 * MiB;
constexpr size_t WS_DIFFB = 872 * MiB, WS_WPB = 936 * MiB;
constexpr size_t WS_XMAX = 1 * MiB + 128 * 1024;
constexpr size_t WS_R1X = 1 * MiB + 256 * 1024;
constexpr size_t WS_X8I = 872 * MiB, WS_W8I = 936 * MiB;
constexpr size_t WS_WORAW = 680 * MiB;
constexpr size_t WS_END = FFN_F8K ? 984 * MiB : 872 * MiB;
constexpr int KF6 = FFN_F8K ? 1792 : 0, XAB = KF6 + 2 * (DM - KF6);
constexpr int KF7 = FFN_F8K ? DFF : 0, ABB = KF7 + 2 * (DFF - KF7);
static_assert(KF6 % 256 == 0 && KF7 % 256 == 0, "fp8 K parts: whole K-tile pairs, whole epilogue column tiles");
constexpr int MIXB = OUT_I8P ? 4096 : OUT_FP8 ? 2048 + 2 * 2048 : 2 * DM;
constexpr int MIX_POOL0 = OUT_FP8 ? 1024 : 2048;
static_assert(WS_WIN + (size_t)NIN_T * DM * 2 <= WS_WOUT && WS_WGU + (size_t)NGU * DM * 2 <= WS_WDN && WS_WDN + (size_t)DM * DFF * 2 <= WS_WPOOL && WS_A + (size_t)M * DFF * 2 <= WS_END, "ws map");

constexpr int SCRATCH_BYTES = 151552;
constexpr int LDSCTL_OFF = SCRATCH_BYTES;
constexpr int LDS_BYTES = 155648;

#define RLX_AGENT __ATOMIC_RELAXED, __HIP_MEMORY_SCOPE_AGENT
#define LDS_WAIT() asm volatile("s_waitcnt lgkmcnt(0)" ::: "memory")
#define VM_WAIT() asm volatile("s_waitcnt vmcnt(0)" ::: "memory")

#define XB_TMO      128
#define XB_XCNT(j)  (256  + 64 * (j))
#define XB_XSUB(j)  (1280 + 64 * (j))
#define XB_XGEN(j)  (2304 + 64 * (j))
#define XB_TOP      3328
#define XB_TOPGEN   3392
#define XCD_BAR_WORDS 3456
#define XB_SPIN_CAP (1u << 18)

__device__ __forceinline__ unsigned xb_ld(unsigned* p)              { return __hip_atomic_load(p, __ATOMIC_RELAXED, __HIP_MEMORY_SCOPE_AGENT); }
__device__ __forceinline__ unsigned xb_add(unsigned* p, unsigned v) { return __hip_atomic_fetch_add(p, v, __ATOMIC_RELAXED, __HIP_MEMORY_SCOPE_AGENT); }
__device__ __forceinline__ unsigned xb_xcc_id() { return (unsigned)__builtin_amdgcn_s_getreg((3 << 11) | 20) & 0xFu; }
#define XB_SPIN(cond, bar) do { unsigned _sp = 0; while (cond) { __builtin_amdgcn_s_sleep(1); \
    if ((++_sp & 255u) == 0u) { if (xb_ld(&(bar)[XB_TMO])) break; if (_sp > XB_SPIN_CAP) { atomicAdd(&(bar)[XB_TMO], 1u); break; } } } } while (0)

__device__ __forceinline__ int fresh_tid(int wave) { int l; asm volatile("v_mbcnt_lo_u32_b32 %0, -1, 0\n\tv_mbcnt_hi_u32_b32 %0, -1, %0" : "=v"(l)); return wave * 64 + l; }

struct XcdBarrier { unsigned* bar; unsigned x; volatile LAS unsigned* st; int wave; };

__device__ __forceinline__ XcdBarrier xcd_barrier_post(unsigned* bar, volatile LAS unsigned* st, int wave) {
    XcdBarrier b; b.bar = bar; b.x = xb_xcc_id(); b.st = st; b.wave = wave;
    if (fresh_tid(wave) == 0) (void)xb_add(&bar[XB_XCNT(b.x)], 1u);
    return b;
}
__device__ __forceinline__ void xcd_barrier_complete(unsigned* bar, unsigned x, unsigned& nloc, unsigned& nx) {
    const unsigned G = gridDim.x * gridDim.y * gridDim.z;
    unsigned sum, cnt, mine, sp = 0u;
    for (;;) {
        sum = 0u; cnt = 0u; mine = 0u;
#pragma unroll
        for (unsigned j = 0; j < 16; ++j) { const unsigned c = xb_ld(&bar[XB_XCNT(j)]); sum += c; cnt += (c > 0u) ? 1u : 0u; mine = (j == x) ? c : mine; }
        if (sum == G) break;
        __builtin_amdgcn_s_sleep(1);
        if ((++sp & 255u) == 0u) { if (xb_ld(&bar[XB_TMO])) break; if (sp > XB_SPIN_CAP) { atomicAdd(&bar[XB_TMO], 1u); break; } }
    }
    nloc = mine > 0u ? mine : 1u; nx = cnt > 0u ? cnt : 1u;
}
__device__ __forceinline__ void xcd_barrier(const XcdBarrier& b) {
    asm volatile("s_waitcnt vmcnt(0)" ::: "memory");
    __syncthreads();
    if (fresh_tid(b.wave) == 0) {
        unsigned* bar = b.bar;
        __builtin_amdgcn_s_waitcnt(0);
        unsigned nloc = b.st[0], nx = b.st[1];
        if (nloc == 0u) { xcd_barrier_complete(bar, b.x, nloc, nx); b.st[0] = nloc; b.st[1] = nx; }
        const unsigned old = xb_add(&bar[XB_XSUB(b.x)], 1u);
        const unsigned gen = old / nloc;
        if (old + 1u == (gen + 1u) * nloc) {
            __builtin_amdgcn_fence(__ATOMIC_RELEASE, "agent");
            asm volatile("s_waitcnt vmcnt(0)" ::: "memory");
            const unsigned og = xb_add(&bar[XB_TOP], 1u);
            const unsigned tg = og / nx;
            if (og + 1u == (tg + 1u) * nx) xb_add(&bar[XB_TOPGEN], 1u);
            else XB_SPIN(xb_ld(&bar[XB_TOPGEN]) == tg, bar);
            __builtin_amdgcn_fence(__ATOMIC_ACQUIRE, "agent");
            xb_add(&bar[XB_XGEN(b.x)], 1u);
            asm volatile("s_waitcnt vmcnt(0)" ::: "memory");
        } else {
            XB_SPIN(xb_ld(&bar[XB_XGEN(b.x)]) == gen, bar);
            __builtin_amdgcn_fence(__ATOMIC_ACQUIRE, "agent");
            asm volatile("s_waitcnt vmcnt(0)" ::: "memory");
        }
    }
    __syncthreads();
}

namespace pg8 {
constexpr int BM = 256, BK = 64, HALF = 128, HTB = HALF * BK * 2, STAGE_BYTES = 8 * HTB, NXCD = 8, WGM = 8;
__host__ __device__ __forceinline__ int lds_byte(int r, int c) { const int st = (r >> 4) * 2 + (c >> 5), rr = r & 15, cc = c & 31, ob = rr * 64 + cc * 2; return st * 1024 + (ob ^ (((ob >> 9) & 1) << 5)); }
__host__ __device__ __forceinline__ void stage_rc(int b, int& R, int& C) { const int st = b / 1024, sb = b % 1024, swz = sb ^ (((sb >> 9) & 1) << 5); R = (st >> 1) * 16 + swz / 64; C = (st & 1) * 32 + (swz % 64) / 2; }
__host__ __device__ __forceinline__ int perm32(int rho) { const int n = rho >> 4, i = rho & 15; return 8 * (i >> 2) + 4 * n + (i & 3); }

constexpr int F8_ALL = 1 << 20;
struct Unit { int pm, pn, half; };
struct Gemm { const char* A; const char* Bt; int lda, ldb, K; int pool; unsigned sc8 = 0x7f7f7f7fu; const float* cs8 = nullptr; const float* rs8 = nullptr; };
__device__ __forceinline__ const char* a_tile(const Gemm& g, const Unit& u) { return g.A + ((size_t)u.pm * 256 + (u.half > 0 ? 128 : 0)) * g.lda * 2 + (g.pool ? (size_t)(u.pn >> 1) * 512 * 2 : 0); }
__device__ __forceinline__ const char* b_tile(const Gemm& g, const Unit& u) { return g.Bt + (size_t)u.pn * 256 * g.ldb * 2; }

struct StaticOrder {
    int nM, nN, nwg, G, c, tail, imax, hbase;
    __host__ __device__ void init(int nM_, int nN_, int G_, int c_, int tail_ = 0) { nM = nM_; nN = nN_; nwg = nM * nN; G = G_; c = c_; tail = tail_; imax = 1 << 30; hbase = -1; }
    __host__ __device__ bool next(int i, Unit& u) const {
        u.half = -1;
        if (tail) { const int L = i * G + c; if (L >= nM) return false; u.pm = L; u.pn = tail; return true; }
        if (i >= imax) return false;
        long L = (long)i * G + c;
        if (hbase >= 0) { if (i > 0) return false; L = (long)hbase + (c >> 1); u.half = c & 1; }
        if (L >= nwg) return false;
        int wgid = (int)L; { const int q = nwg / NXCD, r = nwg % NXCD, xcd = wgid % NXCD, off = wgid / NXCD; wgid = (xcd < r ? xcd * (q + 1) : r * (q + 1) + (xcd - r) * q) + off; }
        const int nig = WGM * nN, gid = wgid / nig, fm = gid * WGM, gsz = (nM - fm) < WGM ? (nM - fm) : WGM;
        u.pm = fm + ((wgid % nig) % gsz); u.pn = (wgid % nig) / gsz; return true;
    }
};

template <class Epi, bool BF = false, bool ALIGN_EPI = true, bool HM = false, bool HN = false, int F8T = 0, bool I8 = false, int I8T = 0>
__device__ __forceinline__ void gemm_phase(LAS unsigned char* lds, const Gemm g, const StaticOrder& S, const Epi& E, const int wid) {
    const int tid = fresh_tid(wid);
    const int lane = tid & 63, wr = wid >> 2, wc = wid & 3, fr = lane & 15, fq = lane >> 4;
    const int K = g.K, nt = K / BK;
    unsigned voffA[2], voffB[2];
#pragma unroll
    for (int i = 0; i < 2; ++i) { int R, C; stage_rc(tid * 16 + i * 8192, R, C); const int Rb = (R & ~31) + perm32(R & 31);
        voffA[i] = (unsigned)(R * g.lda + C) * 2u; voffB[i] = (unsigned)(Rb * g.ldb + C) * 2u; }
    const size_t kstep = (size_t)(BK * 2);
    const size_t hstepA = (size_t)HALF * g.lda * 2, hstepB = (size_t)HALF * g.ldb * 2;
    const unsigned ldsw = (unsigned)wid * 1024u;
    int aoff = lds_byte(wr * 64 + fr, fq * 8), boff = lds_byte(wc * 32 + fr, fq * 8);
#define PG8_SA(b, h) (((b) * 2 + (h)) * HTB)
#define PG8_SB(b, h) ((4 + (b) * 2 + (h)) * HTB)
#define PG8_STAGE(bufoff, gbase, voff) do { _Pragma("unroll") for (int _i = 0; _i < 2; ++_i) { unsigned _vo = (voff)[_i]; asm volatile("" : "+v"(_vo));   \
        __builtin_amdgcn_global_load_lds((const unsigned*)((const char*)(gbase) + _vo), (LAS unsigned*)(lds + (bufoff) + ldsw + _i * 8192), 16, 0, 0); } } while (0)
#define PG8_CAT8(lo, hi) __builtin_bit_cast(i32x8, __builtin_shufflevector(lo, hi, 0, 1, 2, 3, 4, 5, 6, 7))
#define PG8_LDA(dst, b, h) do { if constexpr (F8) { _Pragma("unroll") for (int m = 0; m < 4; ++m) dst##8[m] = PG8_CAT8(*(const LAS u32x4*)(lds + PG8_SA(b, h) + aoff + m * 2048), *(const LAS u32x4*)(lds + PG8_SA(b, h) + aoff + m * 2048 + 1024)); } \
        else { _Pragma("unroll") for (int m = 0; m < 4; ++m) _Pragma("unroll") for (int k = 0; k < 2; ++k) dst[m][k] = *(const LAS f16x8*)(lds + PG8_SA(b, h) + aoff + m * 2048 + k * 1024); } } while (0)
#define PG8_LDB(dst, b, h) do { if constexpr (F8) { _Pragma("unroll") for (int n = 0; n < 2; ++n) dst##8[n] = PG8_CAT8(*(const LAS u32x4*)(lds + PG8_SB(b, h) + boff + n * 2048), *(const LAS u32x4*)(lds + PG8_SB(b, h) + boff + n * 2048 + 1024)); } \
        else { _Pragma("unroll") for (int n = 0; n < 2; ++n) _Pragma("unroll") for (int k = 0; k < 2; ++k) dst[n][k] = *(const LAS f16x8*)(lds + PG8_SB(b, h) + boff + n * 2048 + k * 1024); } } while (0)
#define PG8_MMA(ai, bj, At, Bt) do { if constexpr (F8) { __builtin_amdgcn_s_setprio(1); _Pragma("unroll") for (int m = 0; m < 4; ++m) _Pragma("unroll") for (int n = 0; n < 2; ++n) \
        acc[ai][bj][m][n] = __builtin_amdgcn_mfma_scale_f32_16x16x128_f8f6f4(Bt##8[n], At##8[m], acc[ai][bj][m][n], 0, 0, 0, (int)g.sc8, 0, (int)g.sc8); \
        __builtin_amdgcn_s_setprio(0); } else { __builtin_amdgcn_s_setprio(1); _Pragma("unroll") for (int m = 0; m < 4; ++m) _Pragma("unroll") for (int n = 0; n < 2; ++n) _Pragma("unroll") for (int k = 0; k < 2; ++k) \
        { if constexpr (I8L) acc[ai][bj][m][n] = __builtin_bit_cast(f32x4, __builtin_amdgcn_mfma_i32_16x16x64_i8(__builtin_bit_cast(i32x4, Bt[n][k]), __builtin_bit_cast(i32x4, At[m][k]), __builtin_bit_cast(i32x4, acc[ai][bj][m][n]), 0, 0, 0)); \
          else if constexpr (BF) acc[ai][bj][m][n] = __builtin_amdgcn_mfma_f32_16x16x32_bf16(__builtin_bit_cast(bf16x8, Bt[n][k]), __builtin_bit_cast(bf16x8, At[m][k]), acc[ai][bj][m][n], 0, 0, 0); \
          else acc[ai][bj][m][n] = __builtin_amdgcn_mfma_f32_16x16x32_f16(Bt[n][k], At[m][k], acc[ai][bj][m][n], 0, 0, 0); } __builtin_amdgcn_s_setprio(0); } } while (0)
#define PG8_WAIT_V(n) asm volatile("s_waitcnt vmcnt(" #n ")" ::: "memory")
#define PG8_WAIT_L(n) asm volatile("s_waitcnt lgkmcnt(" #n ")" ::: "memory")
#define PG8_BAR __builtin_amdgcn_s_barrier()
#define PG8_SCHED __builtin_amdgcn_sched_barrier(0)
#define PG8_KBODY \
            const bool last = (t == nt - 2); \
            const char* a1 = cA + (size_t)(t + 1) * kstep; \
            const char* a2 = last ? nA : cA + (size_t)(t + 2) * kstep; const char* b2 = last ? nB : cB + (size_t)(t + 2) * kstep; \
            const char* a3 = a2 + kstep; const char* b3 = b2 + kstep; \
            PG8_LDB(B0, 0, 0); if constexpr (!HN) PG8_LDB(B1, 0, 1); PG8_SCHED; PG8_LDA(At, 0, 0); PG8_STAGE(PG8_SA(1, 1), a1 + hstepA, voffA); \
            PG8_WAIT_V(8); PG8_WAIT_L(0); PG8_BAR; PG8_MMA(0, 0, At, B0); if constexpr (!HN) PG8_MMA(0, 1, At, B1); PG8_BAR; PG8_SCHED; \
            if constexpr (!HM) PG8_LDA(At, 0, 1); PG8_STAGE(PG8_SB(0, 0), b2, voffB); PG8_STAGE(PG8_SB(0, 1), b2 + hstepB, voffB); PG8_STAGE(PG8_SA(0, 0), a2, voffA); \
            PG8_WAIT_V(8); PG8_WAIT_L(0); PG8_BAR; if constexpr (!HM) { PG8_MMA(1, 0, At, B0); if constexpr (!HN) PG8_MMA(1, 1, At, B1); } PG8_BAR; PG8_SCHED; \
            PG8_LDB(B0, 1, 0); if constexpr (!HN) PG8_LDB(B1, 1, 1); PG8_SCHED; PG8_LDA(At, 1, 0); PG8_STAGE(PG8_SA(0, 1), a2 + hstepA, voffA); \
            PG8_WAIT_V(8); PG8_WAIT_L(0); PG8_BAR; PG8_MMA(0, 0, At, B0); if constexpr (!HN) PG8_MMA(0, 1, At, B1); PG8_BAR; PG8_SCHED; \
            if constexpr (!HM) PG8_LDA(At, 1, 1); PG8_STAGE(PG8_SB(1, 0), b3, voffB); PG8_STAGE(PG8_SB(1, 1), b3 + hstepB, voffB); PG8_STAGE(PG8_SA(1, 0), a3, voffA); \
            PG8_WAIT_V(8); PG8_WAIT_L(0); PG8_BAR; if constexpr (!HM) { PG8_MMA(1, 0, At, B0); if constexpr (!HN) PG8_MMA(1, 1, At, B1); } PG8_BAR; PG8_SCHED;
    Unit cur, nxt; int ui = 0;
    if (!S.next(0, cur)) return;
    f32x4 acc[2][2][4][2];
#pragma unroll
    for (int a = 0; a < 2; ++a)
#pragma unroll
        for (int b = 0; b < 2; ++b)
#pragma unroll
            for (int m = 0; m < 4; ++m)
#pragma unroll
                for (int n = 0; n < 2; ++n) acc[a][b][m][n] = (f32x4){0.f, 0.f, 0.f, 0.f};
    f16x8 At[4][2], B0[2][2], B1[2][2]; i32x8 At8[4], B08[2], B18[2];
    const char* cA = a_tile(g, cur); const char* cB = b_tile(g, cur);
    PG8_STAGE(PG8_SB(0, 0), cB, voffB); PG8_STAGE(PG8_SB(0, 1), cB + hstepB, voffB); PG8_STAGE(PG8_SA(0, 0), cA, voffA); PG8_STAGE(PG8_SA(0, 1), cA + hstepA, voffA);
    if (wr == 1) PG8_BAR;
    PG8_WAIT_V(2); PG8_BAR;
    PG8_STAGE(PG8_SB(1, 0), cB + kstep, voffB); PG8_STAGE(PG8_SA(1, 0), cA + kstep, voffA); PG8_STAGE(PG8_SB(1, 1), cB + hstepB + kstep, voffB);
    PG8_WAIT_V(6); PG8_BAR;
    for (;;) {
        const bool has_next = S.next(ui + 1, nxt);
        const char* nA = has_next ? a_tile(g, nxt) : cA; const char* nB = has_next ? b_tile(g, nxt) : cB;
        int t = 0;
        if constexpr (I8T > 0) {
            { constexpr bool F8 = false; constexpr bool I8L = true;
              _Pragma("nounroll") for (; t < I8T; t += 2) { PG8_KBODY } }
            const int te = fresh_tid(wid), fre = te & 15, fqe = (te >> 4) & 3;
            float rsc[2][4];
#pragma unroll
            for (int ai = 0; ai < 2; ++ai)
#pragma unroll
                for (int m = 0; m < 4; ++m) rsc[ai][m] = g.rs8[cur.pm * 256 + ai * 128 + wr * 64 + m * 16 + fre] * (1.0f / (127.0f * 127.0f));
#pragma unroll
            for (int bj = 0; bj < 2; ++bj) { const f32x4* cp = (const f32x4*)(g.cs8 + cur.pn * 256 + bj * 128 + wc * 32 + 8 * fqe); const f32x4 c0 = cp[0], c1 = cp[1];
#pragma unroll
                for (int ai = 0; ai < 2; ++ai)
#pragma unroll
                    for (int m = 0; m < 4; ++m) { const i32x4 i0 = __builtin_bit_cast(i32x4, acc[ai][bj][m][0]), i1 = __builtin_bit_cast(i32x4, acc[ai][bj][m][1]);
                        acc[ai][bj][m][0] = (f32x4){(float)i0[0], (float)i0[1], (float)i0[2], (float)i0[3]} * c0 * rsc[ai][m]; acc[ai][bj][m][1] = (f32x4){(float)i1[0], (float)i1[1], (float)i1[2], (float)i1[3]} * c1 * rsc[ai][m]; } }
        }
        if constexpr (F8T > 0) { constexpr bool F8 = true; constexpr bool I8L = false; const int te8 = F8T < F8_ALL ? F8T : nt;
            _Pragma("nounroll") for (; t < te8; t += 2) { PG8_KBODY } }
        if constexpr (F8T < F8_ALL) { constexpr bool F8 = false; constexpr bool I8L = I8;
            _Pragma("nounroll") for (; t < nt; t += 2) { PG8_KBODY } }
        if constexpr (ALIGN_EPI) { if (wr == 0) PG8_BAR; }
        if constexpr (I8) { if (g.cs8) {
            const int te = fresh_tid(wid), fqe = (te >> 4) & 3;
#pragma unroll
            for (int bj = 0; bj < 2; ++bj) { const f32x4* cp = (const f32x4*)(g.cs8 + cur.pn * 256 + bj * 128 + wc * 32 + 8 * fqe); const f32x4 c0 = cp[0] * (1.0f / 127.0f), c1 = cp[1] * (1.0f / 127.0f);
#pragma unroll
                for (int ai = 0; ai < 2; ++ai)
#pragma unroll
                    for (int m = 0; m < 4; ++m) { const i32x4 i0 = __builtin_bit_cast(i32x4, acc[ai][bj][m][0]), i1 = __builtin_bit_cast(i32x4, acc[ai][bj][m][1]);
                        acc[ai][bj][m][0] = (f32x4){(float)i0[0], (float)i0[1], (float)i0[2], (float)i0[3]} * c0; acc[ai][bj][m][1] = (f32x4){(float)i1[0], (float)i1[1], (float)i1[2], (float)i1[3]} * c1; } }
        } }
        if constexpr (F8T != 0 || I8 || I8T != 0) { const int te = fresh_tid(wid); E(acc, cur, wr, wc, te & 15, (te >> 4) & 3); }
        else E(acc, cur, wr, wc, fr, fq);
        if (!has_next) break;
#pragma unroll
        for (int a = 0; a < 2; ++a)
#pragma unroll
            for (int b = 0; b < 2; ++b)
#pragma unroll
                for (int m = 0; m < 4; ++m)
#pragma unroll
                    for (int n = 0; n < 2; ++n) acc[a][b][m][n] = (f32x4){0.f, 0.f, 0.f, 0.f};
        cur = nxt; cA = nA; cB = nB; ++ui;
        { const int t2 = fresh_tid(wid), fr2 = t2 & 15, fq2 = (t2 >> 4) & 3; aoff = lds_byte(wr * 64 + fr2, fq2 * 8); boff = lds_byte(wc * 32 + fr2, fq2 * 8); }
        if constexpr (ALIGN_EPI) { if (wr == 1) PG8_BAR; }
    }
    PG8_WAIT_V(0);
    if constexpr (!ALIGN_EPI) { if (wr == 0) PG8_BAR; }
    PG8_BAR;
#undef PG8_KBODY
#undef PG8_SA
#undef PG8_SB
#undef PG8_STAGE
#undef PG8_LDA
#undef PG8_LDB
#undef PG8_CAT8
#undef PG8_MMA
#undef PG8_WAIT_V
#undef PG8_WAIT_L
#undef PG8_BAR
#undef PG8_SCHED
}
}

__device__ __forceinline__ unsigned pkh(float lo, float hi) { f16x2 v; v.x = (f16)lo; v.y = (f16)hi; return __builtin_bit_cast(unsigned, v); }
__device__ __forceinline__ unsigned pkb(float lo, float hi) { unsigned r; asm volatile("v_cvt_pk_bf16_f32 %0, %1, %2" : "=v"(r) : "v"(lo), "v"(hi)); return r; }
template <bool BF> __device__ __forceinline__ unsigned pk2t(float lo, float hi) { if constexpr (BF) return pkb(lo, hi); else return pkh(lo, hi); }
template <bool BF> __device__ __forceinline__ u32x4 pk8t(f32x4 a, f32x4 b) { u32x4 w; w.x = pk2t<BF>(a[0], a[1]); w.y = pk2t<BF>(a[2], a[3]); w.z = pk2t<BF>(b[0], b[1]); w.w = pk2t<BF>(b[2], b[3]); return w; }
__device__ __forceinline__ u32x4 pk8(f32x4 a, f32x4 b) { u32x4 w; w.x = pkh(a[0], a[1]); w.y = pkh(a[2], a[3]); w.z = pkh(b[0], b[1]); w.w = pkh(b[2], b[3]); return w; }
__device__ __forceinline__ float wave_sum(float v) {
#pragma unroll
    for (int o = 1; o < 64; o <<= 1) v += __shfl_xor(v, o);
    return v;
}
__device__ __forceinline__ f32x4 shx4(f32x4 v, int m) { f32x4 r; r[0] = __shfl_xor(v[0], m); r[1] = __shfl_xor(v[1], m); r[2] = __shfl_xor(v[2], m); r[3] = __shfl_xor(v[3], m); return r; }

__device__ __forceinline__ void sincos_d(double x, double& s, double& c) {
    const double k = rint(x * 0.63661977236758134308);
    double r = fma(-k, 1.57079632679489655800e+00, x); r = fma(-k, 6.12323399573676603587e-17, r);
    const double r2 = r * r;
    double ps = -1.0 / 1307674368000.0; ps = fma(ps, r2, 1.0 / 6227020800.0); ps = fma(ps, r2, -1.0 / 39916800.0); ps = fma(ps, r2, 1.0 / 362880.0); ps = fma(ps, r2, -1.0 / 5040.0);
    ps = fma(ps, r2, 1.0 / 120.0); ps = fma(ps, r2, -1.0 / 6.0); ps = fma(ps, r2, 1.0); ps *= r;
    double pc = 1.0 / 20922789888000.0; pc = fma(pc, r2, -1.0 / 87178291200.0); pc = fma(pc, r2, 1.0 / 479001600.0); pc = fma(pc, r2, -1.0 / 3628800.0); pc = fma(pc, r2, 1.0 / 40320.0);
    pc = fma(pc, r2, -1.0 / 720.0); pc = fma(pc, r2, 1.0 / 24.0); pc = fma(pc, r2, -0.5); pc = fma(pc, r2, 1.0);
    const int q = ((int)k) & 3;
    s = (q == 0) ? ps : (q == 1) ? pc : (q == 2) ? -ps : -pc;
    c = (q == 0) ? pc : (q == 1) ? -ps : (q == 2) ? -pc : ps;
}

using pg8::Unit;
__device__ __forceinline__ void rope8(f32x4& v0, f32x4& v1, const f32x4 (&cs)[2], const f32x4 (&sn)[2], int xmask, float sgn, bool act) {
    const f32x4 p0 = shx4(v0, xmask), p1 = shx4(v1, xmask);
    if (act) { v0 = v0 * cs[0] + (p0 * sn[0]) * sgn; v1 = v1 * cs[1] + (p1 * sn[1]) * sgn; }
}
__device__ __forceinline__ f32x2 swap32_pair(float x) { const unsigned u = __builtin_bit_cast(unsigned, x); auto t = __builtin_amdgcn_permlane32_swap(u, u, false, false); return __builtin_bit_cast(f32x2, t); }
__device__ __forceinline__ f32x2 swap16_pair(float x) { const unsigned u = __builtin_bit_cast(unsigned, x); auto t = __builtin_amdgcn_permlane16_swap(u, u, false, false); return __builtin_bit_cast(f32x2, t); }
__device__ __forceinline__ float sum_x16_x32(float x) { f32x2 p = swap16_pair(x); x = p[0] + p[1]; p = swap32_pair(x); return p[0] + p[1]; }
__device__ __forceinline__ float max_x16_x32(float x) { f32x2 p = swap16_pair(x); x = fmaxf(p[0], p[1]); p = swap32_pair(x); return fmaxf(p[0], p[1]); }
template <int SEL = 0> struct EpiInT {
    const float* r1; const float *cosA, *sinA, *cosI, *sinI; f16 *Q, *Kb, *Vb, *IQ, *IK, *U; float* IW; int pn_off; float rmul;
    __device__ __forceinline__ void operator()(const f32x4 (&acc)[2][2][4][2], const Unit& u, int wr, int wc, int fr, int fq) const {
        const int pn = u.pn + pn_off;
        const bool ropeA = SEL != 2 && pn < 10 && wc == 0;
        const bool ropeI = SEL != 1 && ((pn >= 12 && pn < 16 && (wc & 1) == 0) || (pn >= 24 && wc == 0));
#pragma unroll
        for (int ab = 0; ab < 4; ++ab) { const int ai = ab >> 1, m0 = (ab & 1) * 2;
            float rs[4]; f32x4 cs[4][2], sn[4][2];
#pragma unroll
            for (int m = m0; m < m0 + 2; ++m) {
                const int row = u.pm * 256 + ai * 128 + wr * 64 + m * 16 + fr, t = row & (SEQ - 1); rs[m] = r1[row] * rmul;
                const float* cp = ropeA ? cosA + t * 16 + 8 * (fq & 1) : cosI + t * 8; const float* sp = ropeA ? sinA + t * 16 + 8 * (fq & 1) : sinI + t * 8;
                if (ropeA || ropeI) { cs[m][0] = *(const f32x4*)cp; cs[m][1] = *(const f32x4*)(cp + 4); sn[m][0] = *(const f32x4*)sp; sn[m][1] = *(const f32x4*)(sp + 4); }
                else { cs[m][0] = cs[m][1] = (f32x4){1.f, 1.f, 1.f, 1.f}; sn[m][0] = sn[m][1] = (f32x4){0.f, 0.f, 0.f, 0.f}; }
            }
            asm volatile("" ::: "memory");
#pragma unroll
            for (int m = m0; m < m0 + 2; ++m) {
                const int row = u.pm * 256 + ai * 128 + wr * 64 + m * 16 + fr;
#pragma unroll
                for (int bj = 0; bj < 2; ++bj) {
                    f32x4 v0 = acc[ai][bj][m][0] * rs[m], v1 = acc[ai][bj][m][1] * rs[m];
                    const int lc = bj * 128 + wc * 32 + 8 * fq;
                    if (SEL == 1 || (SEL == 0 && pn < 12)) {
                        if (ropeA) rope8(v0, v1, cs[m], sn[m], 32, fq < 2 ? -1.f : 1.f, true);
                        if ((K_FP8 && pn >= 8 && pn < 10) || (V_FP8 && pn >= 10)) {
                            int w0 = __builtin_amdgcn_cvt_pk_fp8_f32(v0[0], v0[1], 0, false); w0 = __builtin_amdgcn_cvt_pk_fp8_f32(v0[2], v0[3], w0, true);
                            int w1 = __builtin_amdgcn_cvt_pk_fp8_f32(v1[0], v1[1], 0, false); w1 = __builtin_amdgcn_cvt_pk_fp8_f32(v1[2], v1[3], w1, true);
                            u32x2 w; w.x = (unsigned)w0; w.y = (unsigned)w1; *(u32x2*)((pn < 10 ? (unsigned char*)Kb + (size_t)row * NKV + (pn - 8) * 256 : (unsigned char*)Vb + (size_t)row * NKV + (pn - 10) * 256) + lc) = w;
                        } else {
                        f16* dst = pn < 8 ? Q + (size_t)row * NQ + pn * 256 + lc : pn < 10 ? Kb + (size_t)row * NKV + (pn - 8) * 256 + lc : Vb + (size_t)row * NKV + (pn - 10) * 256 + lc;
                        *(u32x4*)dst = pk8(v0, v1); }
                    } else if (pn < 16) {
                        if (ropeI) rope8(v0, v1, cs[m], sn[m], 16, fq == 0 ? -1.f : 1.f, fq < 2);
                        *(u32x4*)(IQ + (size_t)row * NIQ + (pn - 12) * 256 + lc) = pk8(v0, v1);
                    } else if (pn < 24) {
                        *(u32x4*)(U + (size_t)row * NU + (pn - 16) * 256 + lc) = pk8(v0, v1);
                    } else {
                        if (bj == 0) {
                            if (ropeI) rope8(v0, v1, cs[m], sn[m], 16, fq == 0 ? -1.f : 1.f, fq < 2);
                            if (wc < 2) *(u32x4*)(IK + (size_t)row * NIK + wc * 32 + 8 * fq) = pk8(v0, v1);
                            else if (wc == 2 && fq < 2) { *(f32x4*)(IW + (size_t)row * NIW + 8 * fq) = v0; *(f32x4*)(IW + (size_t)row * NIW + 8 * fq + 4) = v1; }
                        }
                    }
                }
            }
        }
    }
};
typedef EpiInT<0> EpiIn;
struct EpiU8 {
    const float* r1; const float* xmax; const float* cmaxu; f16* U;
    __device__ __forceinline__ void operator()(const f32x4 (&acc)[2][2][4][2], const Unit& u, int wr, int wc, int fr, int fq) const {
        f32x4 cs[2][2];
#pragma unroll
        for (int bj = 0; bj < 2; ++bj) { const f32x4* cp = (const f32x4*)(cmaxu + u.pn * 256 + bj * 128 + wc * 32 + 8 * fq); cs[bj][0] = cp[0] * (1.0f / 127.0f); cs[bj][1] = cp[1] * (1.0f / 127.0f); }
#pragma unroll
        for (int ai = 0; ai < 2; ++ai) {
            float rs[4];
#pragma unroll
            for (int m = 0; m < 4; ++m) { const int row = u.pm * 256 + ai * 128 + wr * 64 + m * 16 + fr; rs[m] = r1[row] * xmax[row] * (1.0f / 127.0f); }
#pragma unroll
            for (int m = 0; m < 4; ++m) { const int row = u.pm * 256 + ai * 128 + wr * 64 + m * 16 + fr;
#pragma unroll
                for (int bj = 0; bj < 2; ++bj) { const i32x4 i0 = __builtin_bit_cast(i32x4, acc[ai][bj][m][0]), i1 = __builtin_bit_cast(i32x4, acc[ai][bj][m][1]);
                    const f32x4 v0 = (f32x4){(float)i0[0], (float)i0[1], (float)i0[2], (float)i0[3]} * cs[bj][0] * rs[m], v1 = (f32x4){(float)i1[0], (float)i1[1], (float)i1[2], (float)i1[3]} * cs[bj][1] * rs[m];
                    *(u32x4*)(U + (size_t)row * NU + u.pn * 256 + bj * 128 + wc * 32 + 8 * fq) = pk8(v0, v1); } }
        }
    }
};
struct EpiPool {
    const float* pscale; f16* MIX; float* wpmax;
    __device__ __forceinline__ void operator()(const f32x4 (&acc)[2][2][4][2], const Unit& u, int wr, int wc, int fr, int fq) const {
#pragma unroll
        for (int bj = 0; bj < 2; ++bj) {
            const int c0 = u.pn * 256 + bj * 128 + wc * 32 + 8 * fq;
            f32x4 s0 = {1.f, 1.f, 1.f, 1.f}, s1 = s0; if (pscale) { s0 = *(const f32x4*)(pscale + c0); s1 = *(const f32x4*)(pscale + c0 + 4); }
#pragma unroll
            for (int ai = 0; ai < 2; ++ai)
#pragma unroll
                for (int m = 0; m < 4; ++m) { const int row = u.pm * 256 + ai * 128 + wr * 64 + m * 16 + fr;
                    const f32x4 w0 = acc[ai][bj][m][0] * s0, w1 = acc[ai][bj][m][1] * s1;
                    if (OUT_I8P && wpmax) { *(u32x4*)(MIX + (size_t)row * 2048 + c0) = pk8t<FFN_BF16 != 0>(w0, w1);
                        float mx = fmaxf(fmaxf(fmaxf(fabsf(w0[0]), fabsf(w0[1])), fmaxf(fabsf(w0[2]), fabsf(w0[3]))), fmaxf(fmaxf(fabsf(w1[0]), fabsf(w1[1])), fmaxf(fabsf(w1[2]), fabsf(w1[3]))));
                        mx = fmaxf(mx, __shfl_xor(mx, 16)); mx = fmaxf(mx, __shfl_xor(mx, 32));
                        if (fq == 0) atomicMax((unsigned*)wpmax + row, __builtin_bit_cast(unsigned, mx)); }
                    else *(u32x4*)(MIX + (size_t)row * (MIXB / 2) + MIX_POOL0 + c0) = pk8t<FFN_BF16 != 0>(w0, w1); }
        }
    }
};
template <bool IN_BF, bool OUT_BF, int XA = 0> struct EpiRes {
    f16* xh; float* ss; unsigned char* xa;
    __device__ __forceinline__ void operator()(const f32x4 (&acc)[2][2][4][2], const Unit& u, int wr, int wc, int fr, int fq) const {
        const int col0 = u.pn * 256 + wc * 32 + 8 * fq;
#pragma unroll
        for (int ai = 0; ai < 2; ++ai) {
            u32x4 xin[4][2];
#pragma unroll
            for (int m = 0; m < 4; ++m)
#pragma unroll
                for (int bj = 0; bj < 2; ++bj) { const size_t r = (size_t)(u.pm * 256 + ai * 128 + wr * 64 + m * 16 + fr);
                    if (XA == 2 && u.pn * 256 >= KF6) xin[m][bj] = *(const u32x4*)(xa + r * XAB + KF6 + (size_t)(col0 + bj * 128 - KF6) * 2);
                    else xin[m][bj] = *(const u32x4*)(xh + r * DM + col0 + bj * 128); }
            asm volatile("" ::: "memory");
#pragma unroll
            for (int m = 0; m < 4; ++m) {
                const int row = u.pm * 256 + ai * 128 + wr * 64 + m * 16 + fr; float q = 0.f, rmx = 0.f;
#pragma unroll
                for (int bj = 0; bj < 2; ++bj) {
                    f32x4 x0, x1;
                    if (IN_BF) { const u32x4 w = xin[m][bj];
                        x0 = (f32x4){__builtin_bit_cast(float, w.x << 16), __builtin_bit_cast(float, w.x & 0xffff0000u), __builtin_bit_cast(float, w.y << 16), __builtin_bit_cast(float, w.y & 0xffff0000u)};
                        x1 = (f32x4){__builtin_bit_cast(float, w.z << 16), __builtin_bit_cast(float, w.z & 0xffff0000u), __builtin_bit_cast(float, w.w << 16), __builtin_bit_cast(float, w.w & 0xffff0000u)}; }
                    else { const f16x8 h = __builtin_bit_cast(f16x8, xin[m][bj]);
                        x0 = (f32x4){(float)h[0], (float)h[1], (float)h[2], (float)h[3]}; x1 = (f32x4){(float)h[4], (float)h[5], (float)h[6], (float)h[7]}; }
                    const f32x4 o0 = x0 + acc[ai][bj][m][0], o1 = x1 + acc[ai][bj][m][1];
                    if (XA != 1 || u.pn * 256 < KF6) *(u32x4*)(xh + (size_t)row * DM + col0 + bj * 128) = pk8t<OUT_BF>(o0, o1);
                    if constexpr (XA == 1) { const int c = col0 + bj * 128;
                        if (u.pn * 256 < KF6) { int w0 = __builtin_amdgcn_cvt_pk_fp8_f32(o0[0] * 4.f, o0[1] * 4.f, 0, false); w0 = __builtin_amdgcn_cvt_pk_fp8_f32(o0[2] * 4.f, o0[3] * 4.f, w0, true);
                            int w1 = __builtin_amdgcn_cvt_pk_fp8_f32(o1[0] * 4.f, o1[1] * 4.f, 0, false); w1 = __builtin_amdgcn_cvt_pk_fp8_f32(o1[2] * 4.f, o1[3] * 4.f, w1, true);
                            u32x2 w; w.x = (unsigned)w0; w.y = (unsigned)w1; *(u32x2*)(xa + (size_t)row * XAB + c) = w; }
                        else *(u32x4*)(xa + (size_t)row * XAB + KF6 + (size_t)(c - KF6) * 2) = pk8t<OUT_BF>(o0, o1); }
                    q += (o0[0] * o0[0] + o0[1] * o0[1]) + (o0[2] * o0[2] + o0[3] * o0[3]) + (o1[0] * o1[0] + o1[1] * o1[1]) + (o1[2] * o1[2] + o1[3] * o1[3]);
                    if constexpr (XA == 3) rmx = fmaxf(rmx, fmaxf(fmaxf(fmaxf(fabsf(o0[0]), fabsf(o0[1])), fmaxf(fabsf(o0[2]), fabsf(o0[3]))), fmaxf(fmaxf(fabsf(o1[0]), fabsf(o1[1])), fmaxf(fabsf(o1[2]), fabsf(o1[3])))));
                }
                q = sum_x16_x32(q);
                if (fq == 0) atomicAdd(ss + row, q);
                if constexpr (XA == 3) { rmx = max_x16_x32(rmx);
                    if (fq == 0) atomicMax((unsigned*)xa + row, __builtin_bit_cast(unsigned, rmx)); }
            }
        }
    }
};
struct EpiGU {
    const float* ss2; f16* Ab; const float* rmax; const float* cmax;
    __device__ __forceinline__ void operator()(const f32x4 (&acc)[2][2][4][2], const Unit& u, int wr, int wc, int fr, int fq) const {
        float ssv[2][4];
#pragma unroll
        for (int ai = 0; ai < 2; ++ai)
#pragma unroll
            for (int m = 0; m < 4; ++m) ssv[ai][m] = (u.half >= 0 && ai == 1) ? 1.f : ss2[u.pm * 256 + (u.half > 0 ? 128 : 0) + ai * 128 + wr * 64 + m * 16 + fr];
        float rmx[2][4]; f32x4 csg[2], csu[2];
        if (GU_I8) {
#pragma unroll
            for (int ai = 0; ai < 2; ++ai)
#pragma unroll
                for (int m = 0; m < 4; ++m) rmx[ai][m] = (u.half >= 0 && ai == 1) ? 1.f : rmax[u.pm * 256 + (u.half > 0 ? 128 : 0) + ai * 128 + wr * 64 + m * 16 + fr];
            const f32x4* cp = (const f32x4*)(cmax + u.pn * 256 + wc * 32 + 8 * fq);
            csg[0] = cp[0]; csg[1] = cp[1]; csu[0] = cp[32]; csu[1] = cp[33];
        }
        f32x4 Gf[2][4][2], Pp[2][4][2];
        if constexpr (GU_I8 && FFN_F8K && KF7 == DFF) {
#pragma unroll
            for (int ai = 0; ai < 2; ++ai)
#pragma unroll
                for (int m = 0; m < 4; ++m)
#pragma unroll
                    for (int n = 0; n < 2; ++n) { const i32x4 gi = __builtin_bit_cast(i32x4, acc[ai][0][m][n]), ui = __builtin_bit_cast(i32x4, acc[ai][1][m][n]);
                        const f32x4 gf = {(float)gi[0], (float)gi[1], (float)gi[2], (float)gi[3]}, uf = {(float)ui[0], (float)ui[1], (float)ui[2], (float)ui[3]};
                        Gf[ai][m][n] = gf; Pp[ai][m][n] = gf * uf; }
            __builtin_amdgcn_sched_barrier(0);
        }
        if (GU_I8) { csg[0] = csg[0] * (1.0f / 127.0f); csg[1] = csg[1] * (1.0f / 127.0f); csu[0] = csu[0] * (1.0f / 127.0f); csu[1] = csu[1] * (1.0f / 127.0f); }
        f32x4 cgn8[2], cgu8[2];
#pragma unroll
        for (int n = 0; n < 2; ++n) { cgn8[n] = csg[n] * -1.44269504089f; cgu8[n] = csg[n] * csu[n]; }
#pragma unroll
        for (int ai = 0; ai < 2; ++ai)
#pragma unroll
            for (int m = 0; m < 4; ++m) {
                if (u.half >= 0 && ai == 1) continue;
                const int row = u.pm * 256 + (u.half > 0 ? 128 : 0) + ai * 128 + wr * 64 + m * 16 + fr;
                float r2 = __builtin_amdgcn_rsqf(ssv[ai][m] * (1.0f / DM) + EPS);
                if (GU_I8) r2 *= rmx[ai][m] * (1.0f / 127.0f);
                const int c = u.pn * 128 + wc * 32 + 8 * fq;
                if constexpr (GU_I8 && FFN_F8K && KF7 == DFF) {
                    const float rr16 = r2 * r2 * 16.0f;
                    int w[2];
#pragma unroll
                    for (int n = 0; n < 2; ++n) {
                        f32x2 t[2];
#pragma unroll
                        for (int h = 0; h < 2; ++h) {
                            const f32x2 gf = {Gf[ai][m][n][2 * h], Gf[ai][m][n][2 * h + 1]}, gu = {Pp[ai][m][n][2 * h], Pp[ai][m][n][2 * h + 1]};
                            const f32x2 cgn = {cgn8[n][2 * h], cgn8[n][2 * h + 1]}, cgu = {cgu8[n][2 * h], cgu8[n][2 * h + 1]};
                            const f32x2 ea = gf * cgn * r2;
                            const f32x2 d = (f32x2){__builtin_amdgcn_exp2f(ea[0]), __builtin_amdgcn_exp2f(ea[1])} + 1.0f;
                            const f32x2 rc = {__builtin_amdgcn_rcpf(d[0]), __builtin_amdgcn_rcpf(d[1])};
                            const f32x2 o = gu * cgu * rr16 * rc;
                            t[h] = (f32x2){__builtin_amdgcn_fmed3f(o[0], -448.f, 448.f), __builtin_amdgcn_fmed3f(o[1], -448.f, 448.f)};
                        }
                        w[n] = __builtin_amdgcn_cvt_pk_fp8_f32(t[0][0], t[0][1], 0, false); w[n] = __builtin_amdgcn_cvt_pk_fp8_f32(t[1][0], t[1][1], w[n], true);
                    }
                    u32x2 ww; ww.x = (unsigned)w[0]; ww.y = (unsigned)w[1]; *(u32x2*)((unsigned char*)Ab + (size_t)row * ABB + c) = ww;
                } else {
                f32x4 o[2];
#pragma unroll
                for (int n = 0; n < 2; ++n) {
                    if (GU_I8) {
                        const i32x4 gi = __builtin_bit_cast(i32x4, acc[ai][0][m][n]), ui = __builtin_bit_cast(i32x4, acc[ai][1][m][n]);
                        const f32x4 gs = csg[n] * r2, gsn = gs * -1.44269504089f, us = csu[n] * r2;
#pragma unroll
                        for (int e = 0; e < 4; ++e) { const float gf = (float)gi[e], gq = gf * gs[e], ex = __builtin_amdgcn_exp2f(gf * gsn[e]); o[n][e] = gq * ((float)ui[e] * us[e]) * __builtin_amdgcn_rcpf(1.0f + ex); }
                    } else { const f32x4 gq = acc[ai][0][m][n] * r2, uq = acc[ai][1][m][n] * r2;
#pragma unroll
                        for (int e = 0; e < 4; ++e) { const float ex = __builtin_amdgcn_exp2f(gq[e] * -1.44269504089f); o[n][e] = gq[e] * uq[e] * __builtin_amdgcn_rcpf(1.0f + ex); } } }
                if (FFN_F8K && u.pn * 128 < KF7) {
                    int w[2];
#pragma unroll
                    for (int n = 0; n < 2; ++n) { f32x4 t;
#pragma unroll
                        for (int e = 0; e < 4; ++e) t[e] = __builtin_amdgcn_fmed3f(o[n][e] * 16.f, -448.f, 448.f);
                        w[n] = __builtin_amdgcn_cvt_pk_fp8_f32(t[0], t[1], 0, false); w[n] = __builtin_amdgcn_cvt_pk_fp8_f32(t[2], t[3], w[n], true); }
                    u32x2 ww; ww.x = (unsigned)w[0]; ww.y = (unsigned)w[1]; *(u32x2*)((unsigned char*)Ab + (size_t)row * ABB + c) = ww;
                } else *(u32x4*)((unsigned char*)Ab + (size_t)row * ABB + KF7 + (size_t)(c - KF7) * 2) = pk8t<FFN_BF16 != 0>(o[0], o[1]);
                }
            }
    }
};

struct Args { const float* in[11]; float* out; unsigned char* ws; float invfA[16]; float invfI[8]; int ph_lo, ph_hi, li, pad; };

struct CvJob { const float* W; const float* gk; f16* Wt; int ldw, K, sc, n, k0, bf; float qs; };
template <int H> __device__ __forceinline__ void cv_issue_half(f32x4 (&r)[16], float (&gs)[16], const CvJob& j, int lane) {
    const float* p = j.W + (size_t)(j.k0 + 32 * H + (lane >> 4)) * j.ldw + (j.sc >= 0 ? j.sc : 0);
#pragma unroll
    for (int i = 0; i < 8; ++i) { r[8 * H + i] = __builtin_nontemporal_load((const f32x4*)p); p += 4 * j.ldw; }
#pragma unroll
    for (int i = 0; i < 8; ++i) gs[8 * H + i] = j.gk ? j.gk[j.k0 + 32 * H + 4 * i + (lane >> 4)] : 1.f;
}
template <bool ZROWS, bool BF> __device__ __forceinline__ void cv_finish(f32x4 (&r)[16], const float (&gs)[16], const CvJob& j) {
    f16* dst = j.Wt + (size_t)j.n * j.K + j.k0;
#pragma unroll
    for (int i = 0; i < 16; ++i) {
        const u32x4 w = __builtin_bit_cast(u32x4, r[i] * gs[i]);
        unsigned e0 = w[0], e1 = w[1], e2 = w[2], e3 = w[3];
        { auto t = __builtin_amdgcn_permlane32_swap(e0, e2, false, false); e0 = t[0]; e2 = t[1]; }
        { auto t = __builtin_amdgcn_permlane32_swap(e1, e3, false, false); e1 = t[0]; e3 = t[1]; }
        { auto t = __builtin_amdgcn_permlane16_swap(e0, e1, false, false); e0 = t[0]; e1 = t[1]; }
        { auto t = __builtin_amdgcn_permlane16_swap(e2, e3, false, false); e2 = t[0]; e3 = t[1]; }
        r[i] = __builtin_bit_cast(f32x4, (u32x4){e0, e1, e2, e3});
    }
#pragma unroll
    for (int q = 0; q < 8; ++q) {
        f32x4 t0 = r[2 * q], t1 = r[2 * q + 1];
        if (ZROWS && j.sc < 0) { t0 = (f32x4){0.f, 0.f, 0.f, 0.f}; t1 = t0; }
        *(u32x4*)(dst + 8 * q) = pk8t<BF>(t0, t1);
    }
}
__device__ __forceinline__ void cv_finish_f8(f32x4 (&r)[16], const float (&gs)[16], const CvJob& j, float scale) {
    unsigned char* dst = (unsigned char*)j.Wt + (size_t)j.n * j.K + j.k0;
#pragma unroll
    for (int i = 0; i < 16; ++i) {
        const u32x4 w = __builtin_bit_cast(u32x4, r[i] * (gs[i] * scale));
        unsigned e0 = w[0], e1 = w[1], e2 = w[2], e3 = w[3];
        { auto t = __builtin_amdgcn_permlane32_swap(e0, e2, false, false); e0 = t[0]; e2 = t[1]; }
        { auto t = __builtin_amdgcn_permlane32_swap(e1, e3, false, false); e1 = t[0]; e3 = t[1]; }
        { auto t = __builtin_amdgcn_permlane16_swap(e0, e1, false, false); e0 = t[0]; e1 = t[1]; }
        { auto t = __builtin_amdgcn_permlane16_swap(e2, e3, false, false); e2 = t[0]; e3 = t[1]; }
        r[i] = __builtin_bit_cast(f32x4, (u32x4){e0, e1, e2, e3});
    }
#pragma unroll
    for (int q = 0; q < 4; ++q) { u32x4 o;
#pragma unroll
        for (int d = 0; d < 4; ++d) { const f32x4 v = r[4 * q + d]; int w0 = __builtin_amdgcn_cvt_pk_fp8_f32(v[0], v[1], 0, false); w0 = __builtin_amdgcn_cvt_pk_fp8_f32(v[2], v[3], w0, true); o[d] = (unsigned)w0; }
        *(u32x4*)(dst + 16 * q) = o; }
}
__device__ __forceinline__ unsigned q8x4(f32x4 v) {
    const unsigned t0 = __builtin_bit_cast(unsigned, v[0] + 12582912.0f), t1 = __builtin_bit_cast(unsigned, v[1] + 12582912.0f), t2 = __builtin_bit_cast(unsigned, v[2] + 12582912.0f), t3 = __builtin_bit_cast(unsigned, v[3] + 12582912.0f);
    return __builtin_amdgcn_perm(t1, t0, 0x0c0c0400u) | __builtin_amdgcn_perm(t3, t2, 0x04000c0cu);
}
__device__ __forceinline__ void cv_finish_i8_64(f32x4 (&r)[16], const float (&gs)[16], const CvJob& j) {
    unsigned char* dst = (unsigned char*)j.Wt + (size_t)j.n * j.K + j.k0;
#pragma unroll
    for (int i = 0; i < 16; ++i) {
        const u32x4 w = __builtin_bit_cast(u32x4, r[i] * gs[i]);
        unsigned e0 = w[0], e1 = w[1], e2 = w[2], e3 = w[3];
        { auto t = __builtin_amdgcn_permlane32_swap(e0, e2, false, false); e0 = t[0]; e2 = t[1]; }
        { auto t = __builtin_amdgcn_permlane32_swap(e1, e3, false, false); e1 = t[0]; e3 = t[1]; }
        { auto t = __builtin_amdgcn_permlane16_swap(e0, e1, false, false); e0 = t[0]; e1 = t[1]; }
        { auto t = __builtin_amdgcn_permlane16_swap(e2, e3, false, false); e2 = t[0]; e3 = t[1]; }
        r[i] = __builtin_bit_cast(f32x4, (u32x4){e0, e1, e2, e3});
    }
    const float s = 127.0f * __builtin_amdgcn_rcpf(fmaxf(j.qs, 1e-30f));
#pragma unroll
    for (int q = 0; q < 4; ++q) { u32x4 o; o.x = q8x4(r[4 * q] * s); o.y = q8x4(r[4 * q + 1] * s); o.z = q8x4(r[4 * q + 2] * s); o.w = q8x4(r[4 * q + 3] * s); *(u32x4*)(dst + 16 * q) = o; }
}
constexpr int CV_IN_N0 = QKV_FP8 ? 3072 : 0;
constexpr int CV_IN_NB = U_I8 ? 20 : (NIN_T - CV_IN_N0) / 64;
#define OUT8_LATE 1
constexpr int CV_E_IN = 64 * CV_IN_NB, CV_E_PL = POOL_FOLD ? 0 : 4 * 8 * 8, CV_E_F8 = QKV_FP8 ? 64 * (3072 / 64) : 0, CV_E_O8 = (OUT_FP8 && !OUT8_LATE) ? 32 * 64 : 0, CV_E_U8 = U_I8 ? 64 * 32 : 0, CV_EARLY = CV_E_IN + CV_E_PL + CV_E_F8 + CV_E_O8 + CV_E_U8;
__device__ __forceinline__ void cv_early_job(const Args& a, int it, int lane, CvJob& j) {
    unsigned char* ws = a.ws;
    const int ng = 4 * (lane & 15), nst = ng + (lane >> 4);
    if (it >= CV_E_IN + CV_E_PL + CV_E_F8 + CV_E_O8) { const int r = it - CV_E_IN - CV_E_PL - CV_E_F8 - CV_E_O8, kb = r >> 5, nb = r & 31;
        j.W = a.in[2]; j.gk = a.in[1]; j.Wt = (f16*)(ws + WS_W8I); j.ldw = IN_W; j.K = DM; j.n = nb * 64 + nst; j.k0 = kb * 64; j.bf = 3; j.sc = 4176 + nb * 64 + ng;
        j.qs = ((const float*)(ws + WS_CTL + CTL_CMAXU))[j.n]; return; }
    if (it >= CV_E_IN + CV_E_PL + CV_E_F8) { const int r = it - CV_E_IN - CV_E_PL - CV_E_F8, kb = r >> 6, nb = r & 63;
        j.W = a.in[5]; j.gk = nullptr; j.Wt = (f16*)(ws + WS_WOUT + (OUT_I8P ? 2048 : 0)); j.ldw = DM; j.K = MIXB; j.n = nb * 64 + nst; j.k0 = kb * 64; j.bf = 2; j.sc = nb * 64 + ng; return; }
    if (it >= CV_E_IN + CV_E_PL) { const int r = it - CV_E_IN - CV_E_PL, nblk = 3072 / 64, kb = r / nblk, nb = r % nblk;
        j.W = a.in[2]; j.gk = a.in[1]; j.Wt = (f16*)(ws + WS_W8); j.ldw = IN_W; j.K = DM; j.n = nb * 64 + nst; j.k0 = kb * 64; j.bf = QKV_I8 ? 3 : 2; j.sc = nb * 64 + ng;
        if (QKV_I8) j.qs = ((const float*)(ws + WS_CTL + CTL_CMAXQ))[j.n]; return; }
    if (it < CV_E_IN) { const int nblk = CV_IN_NB, kb = it / nblk, nbi = it % nblk, nb = U_I8 ? (nbi < 16 ? 48 + nbi : 80 + nbi) : nbi + CV_IN_N0 / 64, n = nb * 64 + ng;
        j.W = a.in[2]; j.gk = a.in[1]; j.Wt = (f16*)(ws + WS_WIN); j.ldw = IN_W; j.K = DM; j.n = nb * 64 + nst; j.k0 = kb * 64; j.bf = 0;
        j.sc = n < 4096 ? n : n < 6144 ? n + 80 : n < 6224 ? n - 2048 : -1; }
    else { const int r = it - CV_E_IN, gq = r >> 6, kb = (r >> 3) & 7, nb = r & 7;
        j.W = a.in[3] + (size_t)gq * 512 * 512; j.gk = nullptr; j.Wt = (f16*)(ws + WS_WPOOL) + (size_t)gq * 512 * 512; j.ldw = 512; j.K = 512; j.n = nb * 64 + nst; j.k0 = kb * 64; j.bf = 0; j.sc = nb * 64 + ng; }
}
constexpr int CV_L_OUT = 64 * 64, CV_L_GU = 64 * (NGU / 64), CV_L_DN = (DFF / 64) * 64, CV_LATE = CV_L_OUT + CV_L_GU + CV_L_DN;
__device__ __forceinline__ void cv_late_job(const Args& a, int it, int lane, CvJob& j) {
    unsigned char* ws = a.ws;
    const int ng = 4 * (lane & 15), nst = ng + (lane >> 4);
    if (it < CV_L_OUT) { const int kb = it >> 6, nb = it & 63;
        j.W = a.in[5]; j.gk = nullptr; j.Wt = (f16*)(ws + WS_WOUT); j.ldw = DM; j.K = DM; j.n = nb * 64 + nst; j.sc = nb * 64 + ng; j.k0 = kb * 64; j.bf = 0; return; }
    it -= CV_L_OUT;
    if (it < CV_L_GU) { const int nblk = NGU / 64, kb = it / nblk, nb = it % nblk, n0 = nb * 64, pn = n0 >> 8, rho = n0 & 255;
        j.W = rho < 128 ? a.in[7] : a.in[8]; j.gk = a.in[6]; j.Wt = (f16*)(ws + WS_WGU); j.ldw = DFF; j.K = DM; j.n = n0 + nst; j.sc = pn * 128 + (rho & 127) + ng; j.k0 = kb * 64; j.bf = FFN_BF16; return; }
    it -= CV_L_GU;
    { const int kb = it >> 6, nb = it & 63;
        j.W = a.in[9]; j.gk = nullptr; j.Wt = (f16*)(ws + WS_WDN); j.ldw = DM; j.K = DFF; j.n = nb * 64 + nst; j.sc = nb * 64 + ng; j.k0 = kb * 64; j.bf = FFN_BF16; }
}

constexpr int CV32_OUT = ((OUT_FP8 ? DM / 2 : DM) / 32) * 64, CV32_GU = (DM / 32) * (NGU / 64), CV32_DN = (DFF / 32) * 64, CV32_O8 = (OUT_FP8 && OUT8_LATE) ? (2048 / 32) * 64 : 0, CV32_LATE = CV32_OUT + CV32_GU + CV32_DN + CV32_O8;
__device__ __forceinline__ void cv32_job(const Args& a, int it, int lane, CvJob& j) {
    unsigned char* ws = a.ws; const int ng = 4 * (lane & 15), nst = ng + (lane >> 4);
    if (it < CV32_OUT) { const int kb = (it >> 8) * 4 + (it & 3), nb = (it >> 2) & 63;
        if (OUT_FP8 && POOL_FOLD) { j.W = a.in[5]; j.gk = nullptr; j.Wt = (f16*)(ws + WS_WORAW) - 2048; j.ldw = DM; j.K = 2048; j.n = nb * 64 + nst; j.sc = nb * 64 + ng; j.k0 = 2048 + kb * 32; j.bf = 0; return; }
        if (OUT_FP8) { j.W = a.in[5]; j.gk = nullptr; j.Wt = (f16*)(ws + WS_WOUT) - 1024; j.ldw = DM; j.K = MIXB / 2; j.n = nb * 64 + nst; j.sc = nb * 64 + ng; j.k0 = 2048 + kb * 32; j.bf = 0; return; }
        j.W = a.in[5]; j.gk = nullptr; j.Wt = (f16*)(ws + WS_WOUT); j.ldw = DM; j.K = DM; j.n = nb * 64 + nst; j.sc = nb * 64 + ng; j.k0 = kb * 32; j.bf = 0; return; }
    it -= CV32_OUT;
    if (it < CV32_GU) { const int nblk = NGU / 64, kb = (it / (4 * nblk)) * 4 + (it & 3), nb = (it >> 2) % nblk, n0 = nb * 64, pn = n0 >> 8, rho = n0 & 255;
        j.W = rho < 128 ? a.in[7] : a.in[8]; j.gk = a.in[6]; j.ldw = DFF; j.n = n0 + nst; j.sc = pn * 128 + (rho & 127) + ng; j.k0 = kb * 32;
        if (GU_I8) { j.Wt = (f16*)(ws + WS_WGU); j.K = DM; j.bf = 3; }
        else if (kb * 32 < KF6) { j.Wt = (f16*)(ws + WS_WGU); j.K = XAB; j.bf = 2; }
        else { j.Wt = (f16*)(ws + WS_WGU) - KF6 / 2; j.K = XAB / 2; j.bf = FFN_BF16; }
        return; }
    it -= CV32_GU;
    { const bool o8 = CV32_O8 > 0 && it >= CV32_DN; if (o8) it -= CV32_DN;
        const int kb = (it >> 8) * 4 + (it & 3), nb = (it >> 2) & 63;
        j.W = o8 ? a.in[5] : a.in[9]; j.gk = nullptr; j.ldw = DM; j.n = nb * 64 + nst; j.sc = nb * 64 + ng; j.k0 = kb * 32;
        if (o8 || kb * 32 < KF7) { j.Wt = (f16*)(ws + (o8 ? WS_WOUT + (OUT_I8P ? 2048 : 0) : WS_WDN)); j.K = o8 ? MIXB : ABB; j.bf = 2; }
        else { j.Wt = (f16*)(ws + WS_WDN) - KF7 / 2; j.K = ABB / 2; j.bf = FFN_BF16; } }
}
__device__ __forceinline__ void cv32_issue(f32x4 (&r)[8], float (&gs)[8], CvJob& j, int lane, const float* cmax = nullptr) {
    j.qs = cmax ? cmax[j.n] : 1.f;
#pragma unroll
    for (int i = 0; i < 8; ++i) gs[i] = 1.f;
    const float* p = j.W + (size_t)(j.k0 + (lane >> 4)) * j.ldw + j.sc;
#pragma unroll
    for (int i = 0; i < 8; ++i) { r[i] = __builtin_nontemporal_load((const f32x4*)p); p += 4 * j.ldw; }
}
__device__ __forceinline__ void cv32_gains(f32x4 (&r)[8], const CvJob& j) {
    if (j.gk) {
#pragma unroll
        for (int i = 0; i < 8; ++i) r[i] = r[i] * *(const __attribute__((address_space(4))) f32x4*)(j.gk + j.k0 + 4 * i);
    }
}
template <bool BF> __device__ __forceinline__ void cv32_finish(f32x4 (&r)[8], const float (&gs)[8], const CvJob& j) {
    f16* dst = j.Wt + (size_t)j.n * j.K + j.k0;
#pragma unroll
    for (int i = 0; i < 8; ++i) {
        const u32x4 w = __builtin_bit_cast(u32x4, r[i] * gs[i]);
        unsigned e0 = w[0], e1 = w[1], e2 = w[2], e3 = w[3];
        { auto t = __builtin_amdgcn_permlane32_swap(e0, e2, false, false); e0 = t[0]; e2 = t[1]; }
        { auto t = __builtin_amdgcn_permlane32_swap(e1, e3, false, false); e1 = t[0]; e3 = t[1]; }
        { auto t = __builtin_amdgcn_permlane16_swap(e0, e1, false, false); e0 = t[0]; e1 = t[1]; }
        { auto t = __builtin_amdgcn_permlane16_swap(e2, e3, false, false); e2 = t[0]; e3 = t[1]; }
        r[i] = __builtin_bit_cast(f32x4, (u32x4){e0, e1, e2, e3});
    }
    cv32_gains(r, j);
#pragma unroll
    for (int q = 0; q < 4; ++q) *(u32x4*)(dst + 8 * q) = pk8t<BF>(r[2 * q], r[2 * q + 1]);
}
__device__ __forceinline__ void cv32_finish_i8(f32x4 (&r)[8], const float (&gs)[8], const CvJob& j) {
    unsigned char* dst = (unsigned char*)j.Wt + (size_t)j.n * j.K + j.k0;
#pragma unroll
    for (int i = 0; i < 8; ++i) {
        const u32x4 w = __builtin_bit_cast(u32x4, r[i] * gs[i]);
        unsigned e0 = w[0], e1 = w[1], e2 = w[2], e3 = w[3];
        { auto t = __builtin_amdgcn_permlane32_swap(e0, e2, false, false); e0 = t[0]; e2 = t[1]; }
        { auto t = __builtin_amdgcn_permlane32_swap(e1, e3, false, false); e1 = t[0]; e3 = t[1]; }
        { auto t = __builtin_amdgcn_permlane16_swap(e0, e1, false, false); e0 = t[0]; e1 = t[1]; }
        { auto t = __builtin_amdgcn_permlane16_swap(e2, e3, false, false); e2 = t[0]; e3 = t[1]; }
        r[i] = __builtin_bit_cast(f32x4, (u32x4){e0, e1, e2, e3});
    }
    cv32_gains(r, j);
    const float s = 127.0f * __builtin_amdgcn_rcpf(fmaxf(j.qs, 1e-30f));
#pragma unroll
    for (int q = 0; q < 4; ++q) { u32x2 o; o.x = q8x4(r[2 * q] * s); o.y = q8x4(r[2 * q + 1] * s); *(u32x2*)(dst + 8 * q) = o; }
}
__device__ __forceinline__ void cv32_finish_f8(f32x4 (&r)[8], const float (&gs)[8], const CvJob& j) {
    unsigned char* dst = (unsigned char*)j.Wt + (size_t)j.n * j.K + j.k0;
#pragma unroll
    for (int i = 0; i < 8; ++i) {
        const u32x4 w = __builtin_bit_cast(u32x4, r[i] * (gs[i] * 64.f));
        unsigned e0 = w[0], e1 = w[1], e2 = w[2], e3 = w[3];
        { auto t = __builtin_amdgcn_permlane32_swap(e0, e2, false, false); e0 = t[0]; e2 = t[1]; }
        { auto t = __builtin_amdgcn_permlane32_swap(e1, e3, false, false); e1 = t[0]; e3 = t[1]; }
        { auto t = __builtin_amdgcn_permlane16_swap(e0, e1, false, false); e0 = t[0]; e1 = t[1]; }
        { auto t = __builtin_amdgcn_permlane16_swap(e2, e3, false, false); e2 = t[0]; e3 = t[1]; }
        r[i] = __builtin_bit_cast(f32x4, (u32x4){e0, e1, e2, e3});
    }
    cv32_gains(r, j);
#pragma unroll
    for (int q = 0; q < 4; ++q) { u32x2 o;
#pragma unroll
        for (int d = 0; d < 2; ++d) { const f32x4 v = r[2 * q + d]; int w0 = __builtin_amdgcn_cvt_pk_fp8_f32(v[0], v[1], 0, false); w0 = __builtin_amdgcn_cvt_pk_fp8_f32(v[2], v[3], w0, true); o[d] = (unsigned)w0; }
        *(u32x2*)(dst + 8 * q) = o; }
}

__device__ __forceinline__ void colmax_ffn(const Args& a, int it0, int it1, int w0, int nw, int lane) {
    float* cmax = (float*)(a.ws + WS_CTL + CTL_CMAX);
    for (int it = it0 + w0; it < it1; it += nw) {
        const int mat = it / (43 * 32), r = it % (43 * 32), cb = r >> 5, kc = r & 31;
        const float* W = (mat ? a.in[8] : a.in[7]) + (size_t)(kc * 128) * DFF + cb * 256 + 4 * lane; const float* gk = a.in[6] + kc * 128;
        f32x4 mx = {0.f, 0.f, 0.f, 0.f};
#pragma unroll 1
        for (int kk = 0; kk < 128; kk += 16) { f32x4 v[16];
#pragma unroll
            for (int j = 0; j < 16; ++j) v[j] = *(const f32x4*)(W + (size_t)(kk + j) * DFF);
#pragma unroll
            for (int j = 0; j < 16; ++j) { const float g = fabsf(gk[kk + j]);
#pragma unroll
                for (int e = 0; e < 4; ++e) mx[e] = fmaxf(mx[e], fabsf(v[j][e]) * g); } }
        const int c = cb * 256 + 4 * lane, row = (c >> 7) * 256 + mat * 128 + (c & 127);
        const u32x4 mb = __builtin_bit_cast(u32x4, mx);
#pragma unroll
        for (int e = 0; e < 4; ++e) atomicMax((unsigned*)cmax + row + e, mb[e]);
    }
}
__device__ __forceinline__ void p0_convert(const Args& a, int vcu, int G, int wave, int lane) {
    const int gw = vcu * NWAVES + wave, NGW = G * NWAVES;
    for (int it = gw; it < CV_EARLY; it += NGW) { CvJob j; f32x4 v[16]; float gs[16]; cv_early_job(a, it, lane, j); cv_issue_half<0>(v, gs, j, lane); cv_issue_half<1>(v, gs, j, lane); if (U_I8 && j.bf == 3) cv_finish_i8_64(v, gs, j); else if (j.bf == 2) cv_finish_f8(v, gs, j, 64.f); else cv_finish<true, false>(v, gs, j); }
}
__device__ __forceinline__ void p0_prologue(const Args& a, LAS unsigned char* lds, int vcu, int G, int wave, int lane) {
    unsigned char* ws = a.ws;
    const float* x = a.in[0];
    const int gw = vcu * NWAVES + wave, NGW = G * NWAVES;
    if (!U_I8) p0_convert(a, vcu, G, wave, lane);
    if (POOL_FOLD) {
        const float* wp = a.in[3]; const float* ps = a.in[4]; f16* o = (f16*)(ws + WS_WPOOL);
        for (int e = (gw * 64 + lane) * 8; e < 4 * 512 * 512; e += NGW * 64 * 8) { const int g = e >> 18, d = e & 511;
            const f32x4 w0 = *(const f32x4*)(wp + e), w1 = *(const f32x4*)(wp + e + 4), p0 = *(const f32x4*)(ps + g * 512 + d), p1 = *(const f32x4*)(ps + g * 512 + d + 4);
            *(u32x4*)(o + e) = pk8t<FFN_BF16 != 0>(w0 * p0, w1 * p1); }
    }
    if (GU_I8) colmax_ffn(a, 0, CMF_SPLIT && ((G % 4 == 0) && G >= 64) ? 43 * 32 : 2 * 43 * 32, gw, NGW, lane);
    if (U_I8) {
        for (int it = gw; it < (QKV_I8 ? 20 : 8) * 32; it += NGW) {
            const int cb0 = it >> 5, kc = it & 31, isq = cb0 >= 8, cb = isq ? cb0 - 8 : cb0;
            float* cmaxu = (float*)(ws + WS_CTL + (isq ? CTL_CMAXQ : CTL_CMAXU));
            const float* W = a.in[2] + (size_t)(kc * 128) * IN_W + (isq ? 0 : 4176) + cb * 256 + 4 * lane; const float* gk = a.in[1] + kc * 128;
            f32x4 mx = {0.f, 0.f, 0.f, 0.f};
#pragma unroll 1
            for (int kk = 0; kk < 128; kk += 16) { f32x4 v[16];
#pragma unroll
                for (int j = 0; j < 16; ++j) v[j] = *(const f32x4*)(W + (size_t)(kk + j) * IN_W);
#pragma unroll
                for (int j = 0; j < 16; ++j) { const float g = fabsf(gk[kk + j]);
#pragma unroll
                    for (int e = 0; e < 4; ++e) mx[e] = fmaxf(mx[e], fabsf(v[j][e]) * g); } }
            const u32x4 mb = __builtin_bit_cast(u32x4, mx);
#pragma unroll
            for (int e = 0; e < 4; ++e) atomicMax((unsigned*)cmaxu + cb * 256 + 4 * lane + e, mb[e]);
        }
    }
    f16* XH = (f16*)(ws + WS_XH); float* R1 = (float*)(ws + WS_R1);
    for (int m = gw; m < M; m += NGW) {
        const f32x4* xr = (const f32x4*)(x + (size_t)m * DM) + lane; u32x2* o8 = (u32x2*)(XH + (size_t)m * DM) + lane; float s = 0.f;
        f32x4 xv[16];
#pragma unroll
        for (int j = 0; j < 16; ++j) xv[j] = __builtin_nontemporal_load(xr + 64 * j);
        asm volatile("" ::: "memory");
#pragma unroll
        for (int j = 0; j < 16; ++j) { const f32x4 v = xv[j]; s += (v[0] * v[0] + v[1] * v[1]) + (v[2] * v[2] + v[3] * v[3]); u32x2 w; w.x = pkh(v[0], v[1]); w.y = pkh(v[2], v[3]); o8[64 * j] = w;
            if (QKV_FP8 && !QKV_I8) { int w8 = __builtin_amdgcn_cvt_pk_fp8_f32(v[0], v[1], 0, false); w8 = __builtin_amdgcn_cvt_pk_fp8_f32(v[2], v[3], w8, true); ((unsigned*)(ws + WS_X8 + (size_t)m * DM))[lane + 64 * j] = (unsigned)w8; } }
        s = wave_sum(s);
        if (lane == 0) R1[m] = 1.0f / sqrtf(s * (1.0f / DM) + EPS);
        if (U_I8) {
            float mxl = 0.f;
#pragma unroll
            for (int j = 0; j < 16; ++j) mxl = fmaxf(mxl, fmaxf(fmaxf(fabsf(xv[j][0]), fabsf(xv[j][1])), fmaxf(fabsf(xv[j][2]), fabsf(xv[j][3]))));
#pragma unroll
            for (int o = 32; o > 0; o >>= 1) mxl = fmaxf(mxl, __shfl_xor(mxl, o));
            const float s8 = 127.0f * __builtin_amdgcn_rcpf(fmaxf(mxl, 1e-30f));
            if (lane == 0) { ((float*)(ws + WS_XMAX))[m] = mxl; ((float*)(ws + WS_R1X))[m] = (1.0f / sqrtf(s * (1.0f / DM) + EPS)) * mxl * (1.0f / 127.0f); }
#pragma unroll
            for (int j = 0; j < 16; ++j) ((unsigned*)(ws + WS_X8I + (size_t)m * DM))[lane + 64 * j] = q8x4(xv[j] * s8);
        }
    }
    const int gt = gw * 64 + lane, NGT = NGW * 64;
    float* cosA = (float*)(ws + WS_COSA); float* sinA = (float*)(ws + WS_SINA); float* cosI = (float*)(ws + WS_COSI); float* sinI = (float*)(ws + WS_SINI);
    for (int e = gt; e < SEQ * 24; e += NGT) {
        double s, c;
        if (e < SEQ * 16) { const int t = e >> 4, i = e & 15; const float ang = (float)t * a.invfA[i]; sincos_d((double)ang, s, c); cosA[e] = (float)c; sinA[e] = (float)s; }
        else { const int e2 = e - SEQ * 16, t = e2 >> 3, i = e2 & 7; const float ang = (float)t * a.invfI[i]; sincos_d((double)ang, s, c); cosI[e2] = (float)c; sinI[e2] = (float)s; }
    }
}

template <int W> __device__ __forceinline__ void pd_sum_prev(const f16* p, float (&s)[8]) {
    f16x8 v[W - 1];
#pragma unroll
    for (int j = 0; j < W - 1; ++j) v[j] = *(const f16x8*)(p - (size_t)(j + 1) * NU);
#pragma unroll
    for (int j = 0; j < W - 1; ++j)
#pragma unroll
        for (int e = 0; e < 8; ++e) s[e] += (float)v[j][e];
}
template <bool TO_MIX> __device__ __forceinline__ void pool_diff_phase(const f16* U, f16* PD, int vcu, int G, int tid, size_t lo = 0, size_t hi = (size_t)M * 256, float* dmax = nullptr) {
    const size_t nth = (size_t)G * 512, gt = (size_t)vcu * 512 + tid;
    for (size_t it = lo + gt; it < hi; it += nth) {
        const int row = (int)(it >> 8), ch = (int)(it & 255), t = row & (SEQ - 1), grp = ch >> 6, w = 2 << grp, cnt = (t + 1) < w ? (t + 1) : w;
        const f16* p = U + (size_t)row * NU + ch * 8;
        const f16x8 cur = *(const f16x8*)p; float s[8];
#pragma unroll
        for (int e = 0; e < 8; ++e) s[e] = (float)cur[e];
        if (t >= 15) { if (grp == 0) pd_sum_prev<2>(p, s); else if (grp == 1) pd_sum_prev<4>(p, s); else if (grp == 2) pd_sum_prev<8>(p, s); else pd_sum_prev<16>(p, s); }
        else for (int j = 1; j < cnt; ++j) { const f16x8 v = *(const f16x8*)(p - (size_t)j * NU);
#pragma unroll
            for (int e = 0; e < 8; ++e) s[e] += (float)v[e]; }
        const float inv = 1.0f / (float)cnt; f32x4 d0, d1;
#pragma unroll
        for (int e = 0; e < 4; ++e) { d0[e] = s[e] * inv - (float)cur[e]; d1[e] = s[e + 4] * inv - (float)cur[e + 4]; }
        if (OUT_I8P && dmax) { *(u32x4*)(PD + (size_t)row * NU + ch * 8) = pk8t<FFN_BF16 != 0>(d0, d1);
            float mx = fmaxf(fmaxf(fmaxf(fabsf(d0[0]), fabsf(d0[1])), fmaxf(fabsf(d0[2]), fabsf(d0[3]))), fmaxf(fmaxf(fabsf(d1[0]), fabsf(d1[1])), fmaxf(fabsf(d1[2]), fabsf(d1[3]))));
#pragma unroll
            for (int o = 32; o > 0; o >>= 1) mx = fmaxf(mx, __shfl_xor(mx, o));
            if ((tid & 63) == 0) atomicMax((unsigned*)dmax + row, __builtin_bit_cast(unsigned, mx)); }
        else if (TO_MIX) *(u32x4*)(PD + (size_t)row * (MIXB / 2) + MIX_POOL0 + ch * 8) = pk8t<FFN_BF16 != 0>(d0, d1);
        else *(u32x4*)(PD + (size_t)row * NU + ch * 8) = pk8(d0, d1);
    }
}

template <int GRP> __device__ __forceinline__ void pd_group(const f16* U, int m, int t, int lane, f32x4& d0, f32x4& d1) {
    constexpr int W = 2 << GRP; const int cnt = (t + 1) < W ? (t + 1) : W;
    const f16* p = U + (size_t)m * NU + (GRP * 64 + lane) * 8;
    const f16x8 cur = *(const f16x8*)p; float s[8];
#pragma unroll
    for (int e = 0; e < 8; ++e) s[e] = (float)cur[e];
    if (t >= 15) pd_sum_prev<W>(p, s);
    else for (int j = 1; j < cnt; ++j) { const f16x8 v = *(const f16x8*)(p - (size_t)j * NU);
#pragma unroll
        for (int e = 0; e < 8; ++e) s[e] += (float)v[e]; }
    const float inv = 1.0f / (float)cnt;
#pragma unroll
    for (int e = 0; e < 4; ++e) { d0[e] = s[e] * inv - (float)cur[e]; d1[e] = s[e + 4] * inv - (float)cur[e + 4]; }
}
__device__ __forceinline__ void pool_diff_rows_i8(const f16* U, unsigned char* mix, float* dmax, int w0, int nw, int lane, int row_lo, int row_hi) {
    for (int m = row_lo + w0; m < row_hi; m += nw) {
        const int t = m & (SEQ - 1);
        f32x4 d[4][2];
        pd_group<0>(U, m, t, lane, d[0][0], d[0][1]); pd_group<1>(U, m, t, lane, d[1][0], d[1][1]); pd_group<2>(U, m, t, lane, d[2][0], d[2][1]); pd_group<3>(U, m, t, lane, d[3][0], d[3][1]);
        float mx = 0.f;
#pragma unroll
        for (int g = 0; g < 4; ++g)
#pragma unroll
            for (int h = 0; h < 2; ++h) mx = fmaxf(mx, fmaxf(fmaxf(fabsf(d[g][h][0]), fabsf(d[g][h][1])), fmaxf(fabsf(d[g][h][2]), fabsf(d[g][h][3]))));
#pragma unroll
        for (int o = 32; o > 0; o >>= 1) mx = fmaxf(mx, __shfl_xor(mx, o));
        const float s8 = 127.0f * __builtin_amdgcn_rcpf(fmaxf(mx, 1e-30f));
        if (lane == 0) dmax[m] = mx;
#pragma unroll
        for (int g = 0; g < 4; ++g) { u32x2 q; q.x = q8x4(d[g][0] * s8); q.y = q8x4(d[g][1] * s8); *(u32x2*)(mix + (size_t)m * MIXB + (g * 64 + lane) * 8) = q; }
    }
}

constexpr int IDX_CAP = 768, IDX_CH = 256, IDX_NE = IDX_CAP / 64;
constexpr int IDX_LDS_IK = 0, IDX_LDS_SC = 2 * IDX_CH * 128  , IDX_LDS_IX = IDX_LDS_SC + 16 * IDX_CAP * 4  , IDX_LDS_END = IDX_LDS_IX + 16 * IDX_CAP * 2  ;
static_assert(IDX_LDS_END <= SCRATCH_BYTES, "indexer LDS");
__device__ __forceinline__ unsigned ord_key(float f) { const unsigned b = __builtin_bit_cast(unsigned, f); return (b & 0x80000000u) ? ~b : (b | 0x80000000u); }
__device__ __forceinline__ float ord_val(unsigned k) { const unsigned b = (k & 0x80000000u) ? (k & 0x7fffffffu) : ~k; return __builtin_bit_cast(float, b); }

__device__ __forceinline__ int wave_sum_i(int v) {
    v += __builtin_amdgcn_update_dpp(0, v, 0xB1, 0xF, 0xF, false);
    v += __builtin_amdgcn_update_dpp(0, v, 0x4E, 0xF, 0xF, false);
    v += __builtin_amdgcn_update_dpp(0, v, 0x141, 0xF, 0xF, false);
    v += __builtin_amdgcn_update_dpp(0, v, 0x140, 0xF, 0xF, false);
    return __builtin_amdgcn_readlane(v, 0) + __builtin_amdgcn_readlane(v, 16) + __builtin_amdgcn_readlane(v, 32) + __builtin_amdgcn_readlane(v, 48);
}
__device__ __forceinline__ unsigned wave_max_u(unsigned v) {
    v = max(v, (unsigned)__builtin_amdgcn_update_dpp(0, (int)v, 0xB1, 0xF, 0xF, false));
    v = max(v, (unsigned)__builtin_amdgcn_update_dpp(0, (int)v, 0x4E, 0xF, 0xF, false));
    v = max(v, (unsigned)__builtin_amdgcn_update_dpp(0, (int)v, 0x141, 0xF, 0xF, false));
    v = max(v, (unsigned)__builtin_amdgcn_update_dpp(0, (int)v, 0x140, 0xF, 0xF, false));
    return max(max((unsigned)__builtin_amdgcn_readlane((int)v, 0), (unsigned)__builtin_amdgcn_readlane((int)v, 16)), max((unsigned)__builtin_amdgcn_readlane((int)v, 32), (unsigned)__builtin_amdgcn_readlane((int)v, 48)));
}
template <int NS> __device__ __forceinline__ unsigned bit_search(const unsigned (&key)[IDX_NE], unsigned T, int hb, int lowbit, int slack) {
#pragma unroll 1
    for (int bit = hb; bit >= lowbit; --bit) {
        const unsigned cand = T | (1u << bit); int c = 0; unsigned long long mk[12];
        asm("v_cmp_le_u32_e64 %0, %6, %7\n\tv_cmp_le_u32_e64 %1, %6, %8\n\tv_cmp_le_u32_e64 %2, %6, %9\n\tv_cmp_le_u32_e64 %3, %6, %10\n\tv_cmp_le_u32_e64 %4, %6, %11\n\tv_cmp_le_u32_e64 %5, %6, %12"
            : "=&s"(mk[0]), "=&s"(mk[1]), "=&s"(mk[2]), "=&s"(mk[3]), "=&s"(mk[4]), "=&s"(mk[5]) : "s"(cand), "v"(key[0]), "v"(key[1]), "v"(key[2]), "v"(key[3]), "v"(key[4]), "v"(key[5]));
        if constexpr (NS > 6) asm("v_cmp_le_u32_e64 %0, %3, %4\n\tv_cmp_le_u32_e64 %1, %3, %5\n\tv_cmp_le_u32_e64 %2, %3, %6" : "=&s"(mk[6]), "=&s"(mk[7]), "=&s"(mk[8]) : "s"(cand), "v"(key[6]), "v"(key[7]), "v"(key[8]));
        if constexpr (NS > 9) asm("v_cmp_le_u32_e64 %0, %3, %4\n\tv_cmp_le_u32_e64 %1, %3, %5\n\tv_cmp_le_u32_e64 %2, %3, %6" : "=&s"(mk[9]), "=&s"(mk[10]), "=&s"(mk[11]) : "s"(cand), "v"(key[9]), "v"(key[10]), "v"(key[11]));
#pragma unroll
        for (int i = 0; i < NS; ++i) c += __builtin_popcountll(mk[i]);
        if (c >= TOPK) T = cand;
        if (c >= TOPK && c <= TOPK + slack) break;
    }
    return T;
}
__device__ __forceinline__ unsigned threshold_search(const unsigned (&key)[IDX_NE], int n, bool coarse) {
    unsigned km = key[0], kn = 0u - key[0];
#pragma unroll
    for (int i = 1; i < IDX_NE; ++i) { km = max(km, key[i]); kn = max(kn, 0u - key[i]); }
    km = wave_max_u(km); const unsigned L = 0u - wave_max_u(kn), R = km - L;
    unsigned off[IDX_NE];
#pragma unroll
    for (int i = 0; i < IDX_NE; ++i) off[i] = __builtin_elementwise_sub_sat(key[i], L);
    const int hb = R ? 31 - __builtin_clz(R) : -1, lowbit = coarse ? (hb > 11 ? hb - 11 : 0) : 0, slack = coarse ? 32 : 0;
    const int ns = (n + 63) >> 6;
    const unsigned To = ns <= 6 ? bit_search<6>(off, 0u, hb, lowbit, slack) : ns <= 9 ? bit_search<9>(off, 0u, hb, lowbit, slack) : bit_search<12>(off, 0u, hb, lowbit, slack);
    return L + To;
}
template <int NBITS>
__device__ __forceinline__ int list_select(LAS float* sc, LAS u16* ix, int n, int lane, float thr_old, float& thr) {
    unsigned key[IDX_NE]; unsigned id[IDX_NE];
#pragma unroll
    for (int i = 0; i < IDX_NE; ++i) { const int e = lane + 64 * i; const float sv = sc[e]; id[i] = ix[e]; key[i] = e < n ? ord_key(sv) : 0u; }
    const unsigned T = threshold_search(key, n, NBITS < 32);
    LDS_WAIT(); asm volatile("" ::: "memory");
    int pos = 0; int rk[IDX_NE];
    const unsigned long long ltm = (1ull << lane) - 1ull;
#pragma unroll
    for (int i = 0; i < IDX_NE; ++i) {
        const bool pr = (lane + 64 * i < n) && key[i] >= T; const unsigned long long mk = __builtin_amdgcn_ballot_w64(pr);
        rk[i] = pr ? pos + __popcll(mk & ltm) : -1;
        pos += __popcll(mk);
    }
#pragma unroll
    for (int i = 0; i < IDX_NE; ++i) if (rk[i] >= 0) { sc[rk[i]] = ord_val(key[i]); ix[rk[i]] = (u16)id[i]; }
    LDS_WAIT(); asm volatile("" ::: "memory");
    thr = ord_val(T);
    return pos;
}
__device__ __forceinline__ void list_final(LAS float* sc, LAS u16* ix, int n, int lane, float thr_old, u16* out) {
    unsigned key[IDX_NE]; unsigned id[IDX_NE];
#pragma unroll
    for (int i = 0; i < IDX_NE; ++i) { const int e = lane + 64 * i; const float sv = sc[e]; id[i] = ix[e]; key[i] = e < n ? ord_key(sv) : 0u; }
    const unsigned T = threshold_search(key, n, false);
    int cgt = 0;
#pragma unroll
    for (int i = 0; i < IDX_NE; ++i) cgt += __popcll(__builtin_amdgcn_ballot_w64((lane + 64 * i < n) && key[i] > T));
    int pg = 0, pe = cgt;
#pragma unroll
    for (int i = 0; i < IDX_NE; ++i) {
        const bool val = (lane + 64 * i < n), gt = val && key[i] > T, eq = val && key[i] == T;
        const unsigned long long mg = __builtin_amdgcn_ballot_w64(gt), me = __builtin_amdgcn_ballot_w64(eq), lt = (1ull << lane) - 1ull;
        const int rg = pg + __popcll(mg & lt), re = pe + __popcll(me & lt);
        if (gt) out[rg] = (u16)id[i];
        if (eq && re < TOPK) out[re] = (u16)id[i];
        pg += __popcll(mg); pe += __popcll(me);
    }
}

struct CvRun { int next, stride, tick, pend; };

template <int PMODE = 0> __device__ __forceinline__ void indexer_unit(const Args& a, CvRun& cv, const f16* IQ, const f16* IK, const float* IW, u16* TK, LAS unsigned char* lds, int b, int qt, int tid, int wave, int lane) {
    const int t0 = qt * 16, m0 = b * SEQ + t0, hh = lane >> 5, l31 = lane & 31;
    const int myq = 2 * wave + hh, tq = t0 + myq;
    const int aq = (l31 >> 2) & 1, ah = (l31 & 3) + 4 * (l31 >> 3);
    const f16* iqp = IQ + (size_t)(m0 + 2 * wave + aq) * NIQ + ah * 64 + 8 * hh;
    f16x8 afr[4];
#pragma unroll
    for (int s = 0; s < 4; ++s) afr[s] = *(const f16x8*)(iqp + 16 * s);
    float wv[16];
    { const f32x4* wp = (const f32x4*)(IW + (size_t)(m0 + myq) * NIW);
#pragma unroll
      for (int i = 0; i < 4; ++i) { const f32x4 v = wp[i]; wv[4 * i] = v[0] * 0.03125f; wv[4 * i + 1] = v[1] * 0.03125f; wv[4 * i + 2] = v[2] * 0.03125f; wv[4 * i + 3] = v[3] * 0.03125f; } }
    LAS float* scq = (LAS float*)(lds + IDX_LDS_SC) + myq * IDX_CAP; LAS u16* ixq = (LAS u16*)(lds + IDX_LDS_IX) + myq * IDX_CAP;
    int cnt = 0; float thr = -INFINITY;
    const int nkeys = t0 + 16, nch = (nkeys + IDX_CH - 1) / IDX_CH;
    const f16* ikb = IK + (size_t)b * SEQ * NIK;
    int boffs[4];
#pragma unroll
    for (int s = 0; s < 4; ++s) boffs[s] = 128 * l31 + 16 * ((2 * s + hh) ^ ((l31 >> 1) & 7));
#define IDX_DMA(c_) do { _Pragma("unroll") for (int i_ = 0; i_ < 4; ++i_) { const int j_ = wave * 4 + i_, r_ = 8 * j_ + (lane >> 3); \
        __builtin_amdgcn_global_load_lds((const unsigned*)(ikb + (size_t)((c_) * IDX_CH + r_) * NIK + 8 * ((lane & 7) ^ ((r_ >> 1) & 7))), (LAS unsigned*)(lds + IDX_LDS_IK + ((c_) & 1) * 32768 + 1024 * j_), 16, 0, 0); } } while (0)
    __syncthreads();
    int young = 0;
    IDX_DMA(0);
    for (int c = 0; c < nch; ++c) {
        if (young == 4) asm volatile("s_waitcnt vmcnt(4) lgkmcnt(0)\n\ts_barrier" ::: "memory");
        else asm volatile("s_waitcnt vmcnt(0) lgkmcnt(0)\n\ts_barrier" ::: "memory");
        young = 0;
        if (c + 1 < nch) IDX_DMA(c + 1);
        const bool cvh = (PMODE == 0) && cv.next < CV32_LATE;
        CvJob cj; f32x4 cvv[8]; float cvg[8];
        if (cvh) { cv32_job(a, cv.next, lane, cj); cv32_issue(cvv, cvg, cj, lane, (const float*)(a.ws + WS_CTL + CTL_CMAX)); cv.next += cv.stride; }
        const bool forced = (c == 3) | (c == 6) | (c == 12) | (c == 24);
#pragma unroll 1
        for (int h2 = 0; h2 < 2; ++h2) {
            const int ch = __builtin_amdgcn_readlane(cnt, 32 * h2);
            if (PMODE != 1 && ((forced && ch > TOPK) || ch + IDX_CH > IDX_CAP)) {
                LAS float* s2 = (LAS float*)(lds + IDX_LDS_SC) + (2 * wave + h2) * IDX_CAP; LAS u16* i2 = (LAS u16*)(lds + IDX_LDS_IX) + (2 * wave + h2) * IDX_CAP;
                const float tho = __builtin_bit_cast(float, __builtin_amdgcn_readlane(__builtin_bit_cast(int, thr), 32 * h2));
                float th; int nn = list_select<12>(s2, i2, ch, lane, tho, th);
                if (nn + IDX_CH > IDX_CAP) nn = list_select<32>(s2, i2, nn, lane, th, th);
                if (hh == h2) { cnt = nn; thr = th; }
            }
        }
        const int kbase = c * IDX_CH; int ntile = (nkeys - kbase + 31) >> 5; ntile = ntile > 8 ? 8 : ntile; if (PMODE == 2) ntile = 0;
        const LAS unsigned char* cb = lds + IDX_LDS_IK + (c & 1) * 32768;
        f16x8 bfr[4];
#pragma unroll
        for (int s = 0; s < 4; ++s) bfr[s] = *(const LAS f16x8*)(cb + boffs[s]);
#pragma unroll 1
        for (int tl = 0; tl < ntile; ++tl) {
            f32x16 acc;
#pragma unroll
            for (int r = 0; r < 16; ++r) acc[r] = 0.f;
#pragma unroll
            for (int s = 0; s < 4; ++s) acc = __builtin_amdgcn_mfma_f32_32x32x16_f16(afr[s], bfr[s], acc, 0, 0, 0);
            if (tl + 1 < ntile) {
#pragma unroll
                for (int s = 0; s < 4; ++s) bfr[s] = *(const LAS f16x8*)(cb + (tl + 1) * 4096 + boffs[s]); }
            float t[16]; typedef int i32x16_t __attribute__((ext_vector_type(16))); const i32x16_t ai = __builtin_bit_cast(i32x16_t, acc);
#pragma unroll
            for (int r = 0; r < 16; ++r) { const int ib = ai[r]; t[r] = __builtin_bit_cast(float, ib > 0 ? ib : 0); }
            float sc0 = wv[0] * t[0], sc1 = wv[1] * t[1], sc2 = wv[2] * t[2], sc3 = wv[3] * t[3];
#pragma unroll
            for (int r = 4; r < 16; r += 4) { sc0 = __builtin_fmaf(wv[r], t[r], sc0); sc1 = __builtin_fmaf(wv[r + 1], t[r + 1], sc1); sc2 = __builtin_fmaf(wv[r + 2], t[r + 2], sc2); sc3 = __builtin_fmaf(wv[r + 3], t[r + 3], sc3); }
            sc0 += sc2; sc1 += sc3;
            const float score = sc0 + sc1;
            const int key = kbase + tl * 32 + l31;
            const bool p1 = key <= tq, p2 = score >= thr, pr = p1 && p2;
            const unsigned long long mk = __builtin_amdgcn_ballot_w64(p1) & __builtin_amdgcn_ballot_w64(p2);
            const unsigned hm = hh ? (unsigned)(mk >> 32) : (unsigned)mk;
            const int rank = cnt + __popc(hm & ((1u << l31) - 1u));
            if (pr && (PMODE != 1 || rank < IDX_CAP)) { scq[rank] = score; ixq[rank] = (u16)key; }
            cnt += __popc(hm);
        }
        if (cvh) { asm volatile("" :: "v"(cj.qs)); if (GU_I8 && cj.bf == 3) cv32_finish_i8(cvv, cvg, cj); else if (FFN_F8K && cj.bf == 2) cv32_finish_f8(cvv, cvg, cj); else cv32_finish<FFN_BF16 != 0>(cvv, cvg, cj); young = 4; }
    }
#undef IDX_DMA
    LDS_WAIT(); asm volatile("" ::: "memory");
#pragma unroll 1
    for (int h2 = 0; h2 < 2; ++h2) {
        int n = __builtin_amdgcn_readlane(cnt, 32 * h2); n = n > IDX_CAP ? IDX_CAP : n;
        LAS float* s2 = (LAS float*)(lds + IDX_LDS_SC) + (2 * wave + h2) * IDX_CAP; LAS u16* i2 = (LAS u16*)(lds + IDX_LDS_IX) + (2 * wave + h2) * IDX_CAP;
        u16* out = TK + (size_t)(m0 + 2 * wave + h2) * TOPK;
        if (n <= TOPK || PMODE == 1) {
#pragma unroll
            for (int i = 0; i < 4; ++i) { const int e = lane + 64 * i; out[e] = e < n ? i2[e] : (u16)0; }
        } else list_final(s2, i2, n, lane, __builtin_bit_cast(float, __builtin_amdgcn_readlane(__builtin_bit_cast(int, thr), 32 * h2)), out);
    }
}
template <int PMODE = 0> __device__ __forceinline__ void indexer_phase(const Args& a, const f16* IQ, const f16* IK, const float* IW, u16* TK, LAS unsigned char* lds, int bid, int G, int tid, int wave, int lane, int cv0 = 0) {
    CvRun cv; cv.next = PMODE ? CV_LATE : cv0 + bid * NWAVES + wave; cv.stride = G * NWAVES; cv.tick = 0; cv.pend = 0;
    for (int p = bid; p < 512; p += G) {
        const int b = p >> 8, j = p & 255;
        indexer_unit<PMODE>(a, cv, IQ, IK, IW, TK, lds, b, j, tid, wave, lane);
        indexer_unit<PMODE>(a, cv, IQ, IK, IW, TK, lds, b, 511 - j, tid, wave, lane);
    }
    if (PMODE == 0) {
        for (; cv.next < CV32_LATE; cv.next += cv.stride) { CvJob cj; f32x4 v[8]; float gs[8]; cv32_job(a, cv.next, lane, cj); cv32_issue(v, gs, cj, lane, (const float*)(a.ws + WS_CTL + CTL_CMAX)); asm volatile("" :: "v"(cj.qs)); if (GU_I8 && cj.bf == 3) cv32_finish_i8(v, gs, cj); else if (FFN_F8K && cj.bf == 2) cv32_finish_f8(v, gs, cj); else cv32_finish<FFN_BF16 != 0>(v, gs, cj); }
    }
    __syncthreads();
}

constexpr int SA_WAVE_BYTES = 16384 + 1024;
static_assert(NWAVES * SA_WAVE_BYTES <= SCRATCH_BYTES, "sparse attention LDS");
#define SA_TR16(O0, O1, r, ad) asm volatile( \
    "ds_read_b64_tr_b16 %0, %16 offset:" #O0 "\n\tds_read_b64_tr_b16 %1, %16 offset:" #O1 "\n\tds_read_b64_tr_b16 %2, %17 offset:" #O0 "\n\tds_read_b64_tr_b16 %3, %17 offset:" #O1 "\n\t" \
    "ds_read_b64_tr_b16 %4, %18 offset:" #O0 "\n\tds_read_b64_tr_b16 %5, %18 offset:" #O1 "\n\tds_read_b64_tr_b16 %6, %19 offset:" #O0 "\n\tds_read_b64_tr_b16 %7, %19 offset:" #O1 "\n\t" \
    "ds_read_b64_tr_b16 %8, %20 offset:" #O0 "\n\tds_read_b64_tr_b16 %9, %20 offset:" #O1 "\n\tds_read_b64_tr_b16 %10, %21 offset:" #O0 "\n\tds_read_b64_tr_b16 %11, %21 offset:" #O1 "\n\t" \
    "ds_read_b64_tr_b16 %12, %22 offset:" #O0 "\n\tds_read_b64_tr_b16 %13, %22 offset:" #O1 "\n\tds_read_b64_tr_b16 %14, %23 offset:" #O0 "\n\tds_read_b64_tr_b16 %15, %23 offset:" #O1 "\n\t" \
    "s_waitcnt lgkmcnt(0)" \
    : "=&v"(r[0]), "=&v"(r[1]), "=&v"(r[2]), "=&v"(r[3]), "=&v"(r[4]), "=&v"(r[5]), "=&v"(r[6]), "=&v"(r[7]), "=&v"(r[8]), "=&v"(r[9]), "=&v"(r[10]), "=&v"(r[11]), "=&v"(r[12]), "=&v"(r[13]), "=&v"(r[14]), "=&v"(r[15]) \
    : "v"(ad[0]), "v"(ad[1]), "v"(ad[2]), "v"(ad[3]), "v"(ad[4]), "v"(ad[5]), "v"(ad[6]), "v"(ad[7]) : "memory")

#define SA_GATHER(base_, tp_) do { _Pragma("unroll") for (int i_ = 0; i_ < 16; ++i_) { const int row_ = 4 * i_ + g; const int kid_ = idl[64 * (tp_) + row_]; \
        __builtin_amdgcn_global_load_lds((const unsigned*)((base_) + (size_t)kid_ * (NKV * 2) + 16 * (c ^ (row_ & 15))), (LAS unsigned*)(tile + 1024 * i_), 16, 0, 0); } } while (0)
#define SA_CV_AND_WAIT(GRP) asm volatile("s_waitcnt vmcnt(0)" ::: "memory")

__device__ __forceinline__ void sparse_attn_phase(const Args& a, const f16* Q, const f16* Kb, const f16* Vb, const u16* TK, f16* MIX, LAS unsigned char* lds, LAS unsigned* qctr, int bid, int G, int wave, int lane) {
    LAS unsigned char* tile = lds + wave * SA_WAVE_BYTES; LAS u16* idl = (LAS u16*)(tile + 16384);
    const unsigned tile_addr = (unsigned)(size_t)tile;
    const int c = lane & 15, g = lane >> 4, q4 = c >> 2, p4 = c & 3;
    const float sc2 = 0.08838834764831845f * 1.44269504089f;
    unsigned trad[8];
#pragma unroll
    for (int db = 0; db < 8; ++db) trad[db] = tile_addr + 256 * (4 * g + q4) + 16 * ((2 * db + (p4 >> 1)) ^ (4 * g + q4)) + 8 * (p4 & 1);
    for (;;) {
        int ticket = 0; if (lane == 0) ticket = (int)__hip_atomic_fetch_add(qctr, 1u, __ATOMIC_RELAXED, __HIP_MEMORY_SCOPE_WORKGROUP);
        ticket = __builtin_amdgcn_readfirstlane(ticket);
        const long item = (long)bid + (long)ticket * G;
        if (item >= 8L * SEQ) break;
        const int pair = (int)(item & 7), t = (int)(item >> 3), b = pair >> 2, kvh = pair & 3, m = b * SEQ + t, cnt = (t + 1) < TOPK ? (t + 1) : TOPK;
        { const u32x2 w = *(const u32x2*)(TK + (size_t)m * TOPK + 4 * lane); *(LAS u32x2*)(idl + 4 * lane) = w; }
        f16x8 qf[4];
#pragma unroll
        for (int s = 0; s < 4; ++s) { f16x8 z; for (int e = 0; e < 8; ++e) z[e] = (f16)0.f; qf[s] = c < 4 ? *(const f16x8*)(Q + (size_t)m * NQ + (4 * kvh + c) * 128 + 32 * s + 8 * g) : z; }
        LDS_WAIT(); asm volatile("" ::: "memory");
        f32x4 sacc[16];
#pragma unroll
        for (int i = 0; i < 16; ++i) sacc[i] = (f32x4){0.f, 0.f, 0.f, 0.f};
        const char* kbase = (const char*)(Kb + (size_t)b * SEQ * NKV + kvh * 128);
        const char* vbase = (const char*)(Vb + (size_t)b * SEQ * NKV + kvh * 128);
#define SA_KSTAGE(tp) do { SA_GATHER(kbase, tp); SA_CV_AND_WAIT(tp); \
            _Pragma("unroll") for (int sub = 0; sub < 4; ++sub) _Pragma("unroll") for (int s = 0; s < 4; ++s) { const int row = 16 * sub + c; \
                const f16x8 kf = *(const LAS f16x8*)(tile + 256 * row + 16 * ((4 * s + g) ^ (row & 15))); \
                sacc[4 * (tp) + sub] = __builtin_amdgcn_mfma_f32_16x16x32_f16(kf, qf[s], sacc[4 * (tp) + sub], 0, 0, 0); } \
            LDS_WAIT(); asm volatile("" ::: "memory"); __builtin_amdgcn_sched_barrier(0); } while (0)
#if K_FP8
        long q8[4];
#pragma unroll
        for (int s = 0; s < 4; ++s) { int w0 = __builtin_amdgcn_cvt_pk_fp8_f32((float)qf[s][0], (float)qf[s][1], 0, false); w0 = __builtin_amdgcn_cvt_pk_fp8_f32((float)qf[s][2], (float)qf[s][3], w0, true);
            int w1 = __builtin_amdgcn_cvt_pk_fp8_f32((float)qf[s][4], (float)qf[s][5], 0, false); w1 = __builtin_amdgcn_cvt_pk_fp8_f32((float)qf[s][6], (float)qf[s][7], w1, true);
            q8[s] = (long)(((unsigned long long)(unsigned)w1 << 32) | (unsigned)w0); }
        const char* k8base = (const char*)Kb + (size_t)b * SEQ * NKV + kvh * 128;
#define SA_KSTAGE8(tp) do { _Pragma("unroll") for (int i_ = 0; i_ < 16; ++i_) { const int row_ = 8 * i_ + (lane >> 3); const int kid_ = idl[128 * (tp) + row_]; \
                __builtin_amdgcn_global_load_lds((const unsigned*)(k8base + (size_t)kid_ * NKV + 16 * ((lane & 7) ^ ((row_ >> 1) & 7))), (LAS unsigned*)(tile + 1024 * i_), 16, 0, 0); } \
            asm volatile("s_waitcnt vmcnt(0)" ::: "memory"); \
            _Pragma("unroll") for (int sub = 0; sub < 8; ++sub) _Pragma("unroll") for (int s = 0; s < 4; ++s) { const int row = 16 * sub + c; \
                const long kf = *(const LAS long*)(tile + 128 * row + 16 * ((2 * s + (g >> 1)) ^ ((row >> 1) & 7)) + 8 * (g & 1)); \
                sacc[8 * (tp) + sub] = __builtin_amdgcn_mfma_f32_16x16x32_fp8_fp8(kf, q8[s], sacc[8 * (tp) + sub], 0, 0, 0); } \
            LDS_WAIT(); asm volatile("" ::: "memory"); __builtin_amdgcn_sched_barrier(0); } while (0)
        SA_KSTAGE8(0); SA_KSTAGE8(1);
#undef SA_KSTAGE8
#else
        SA_KSTAGE(0); SA_KSTAGE(1); SA_KSTAGE(2); SA_KSTAGE(3);
#endif
        float mx = -INFINITY;
#pragma unroll
        for (int T = 0; T < 16; ++T)
#pragma unroll
            for (int j = 0; j < 4; ++j) { const float s = (16 * T + 4 * g + j) < cnt ? sacc[T][j] * sc2 : -INFINITY; sacc[T][j] = s; mx = fmaxf(mx, s); }
        mx = fmaxf(mx, __shfl_xor(mx, 16)); mx = fmaxf(mx, __shfl_xor(mx, 32));
        float sum = 0.f;
#pragma unroll
        for (int T = 0; T < 16; ++T)
#pragma unroll
            for (int j = 0; j < 4; ++j) { const float p = __builtin_amdgcn_exp2f(sacc[T][j] - mx); sacc[T][j] = p; sum += p; }
        sum += __shfl_xor(sum, 16); sum += __shfl_xor(sum, 32);
        f16x8 pf[8];
#pragma unroll
        for (int u = 0; u < 8; ++u) { f16x8 v;
#pragma unroll
            for (int j = 0; j < 4; ++j) { v[j] = (f16)sacc[2 * u][j]; v[4 + j] = (f16)sacc[2 * u + 1][j]; }
            pf[u] = v; }
        f32x4 oacc[8];
#pragma unroll
        for (int i = 0; i < 8; ++i) oacc[i] = (f32x4){0.f, 0.f, 0.f, 0.f};
#define SA_PV(r, u) do { _Pragma("unroll") for (int db = 0; db < 8; ++db) { f16x8 vf; vf[0] = r[2 * db][0]; vf[1] = r[2 * db][1]; vf[2] = r[2 * db][2]; vf[3] = r[2 * db][3]; \
                vf[4] = r[2 * db + 1][0]; vf[5] = r[2 * db + 1][1]; vf[6] = r[2 * db + 1][2]; vf[7] = r[2 * db + 1][3]; \
                oacc[db] = __builtin_amdgcn_mfma_f32_16x16x32_f16(vf, pf[u], oacc[db], 0, 0, 0); } } while (0)
#define SA_VSTAGE(tp) do { SA_GATHER(vbase, tp); SA_CV_AND_WAIT(4 + (tp)); \
            { f16x4 r0[16]; SA_TR16(0, 4096, r0, trad); __builtin_amdgcn_sched_barrier(0); SA_PV(r0, 2 * (tp)); } \
            { f16x4 r1[16]; SA_TR16(8192, 12288, r1, trad); __builtin_amdgcn_sched_barrier(0); SA_PV(r1, 2 * (tp) + 1); } \
            LDS_WAIT(); asm volatile("" ::: "memory"); __builtin_amdgcn_sched_barrier(0); } while (0)
#if V_FP8
        long p8[8];
#pragma unroll
        for (int u = 0; u < 8; ++u) { int w0 = __builtin_amdgcn_cvt_pk_fp8_f32(sacc[2 * u][0], sacc[2 * u][1], 0, false); w0 = __builtin_amdgcn_cvt_pk_fp8_f32(sacc[2 * u][2], sacc[2 * u][3], w0, true);
            int w1 = __builtin_amdgcn_cvt_pk_fp8_f32(sacc[2 * u + 1][0], sacc[2 * u + 1][1], 0, false); w1 = __builtin_amdgcn_cvt_pk_fp8_f32(sacc[2 * u + 1][2], sacc[2 * u + 1][3], w1, true);
            p8[u] = (long)(((unsigned long long)(unsigned)w1 << 32) | (unsigned)w0); }
        const char* v8base = (const char*)Vb + (size_t)b * SEQ * NKV + kvh * 128;
        unsigned trad8[8];
        { const int rr = c >> 1, cc = c & 1, rowl = rr < 4 ? 4 * g + rr : 16 + 4 * g + (rr - 4), fl = ((rowl >> 1) & 3) | (((rowl >> 4) & 1) << 2);
#pragma unroll
          for (int db = 0; db < 8; ++db) trad8[db] = tile_addr + 128 * rowl + 16 * (db ^ fl) + 8 * cc; }
#define SA_TR8(OFF, r, ad) asm volatile( \
            "ds_read_b64_tr_b8 %0, %8 offset:" #OFF "\n\tds_read_b64_tr_b8 %1, %9 offset:" #OFF "\n\tds_read_b64_tr_b8 %2, %10 offset:" #OFF "\n\tds_read_b64_tr_b8 %3, %11 offset:" #OFF "\n\t" \
            "ds_read_b64_tr_b8 %4, %12 offset:" #OFF "\n\tds_read_b64_tr_b8 %5, %13 offset:" #OFF "\n\tds_read_b64_tr_b8 %6, %14 offset:" #OFF "\n\tds_read_b64_tr_b8 %7, %15 offset:" #OFF "\n\t" \
            "s_waitcnt lgkmcnt(0)" \
            : "=&v"(r[0]), "=&v"(r[1]), "=&v"(r[2]), "=&v"(r[3]), "=&v"(r[4]), "=&v"(r[5]), "=&v"(r[6]), "=&v"(r[7]) \
            : "v"(ad[0]), "v"(ad[1]), "v"(ad[2]), "v"(ad[3]), "v"(ad[4]), "v"(ad[5]), "v"(ad[6]), "v"(ad[7]) : "memory")
#define SA_PV8(OFF, u) do { long r8[8]; SA_TR8(OFF, r8, trad8); __builtin_amdgcn_sched_barrier(0); \
            _Pragma("unroll") for (int db = 0; db < 8; ++db) oacc[db] = __builtin_amdgcn_mfma_f32_16x16x32_fp8_fp8(r8[db], p8[u], oacc[db], 0, 0, 0); } while (0)
#define SA_VSTAGE8(tp) do { _Pragma("unroll") for (int i_ = 0; i_ < 16; ++i_) { const int row_ = 8 * i_ + (lane >> 3); const int kid_ = idl[128 * (tp) + row_]; \
                __builtin_amdgcn_global_load_lds((const unsigned*)(v8base + (size_t)kid_ * NKV + 16 * ((lane & 7) ^ (((row_ >> 1) & 3) | (((row_ >> 4) & 1) << 2)))), (LAS unsigned*)(tile + 1024 * i_), 16, 0, 0); } \
            asm volatile("s_waitcnt vmcnt(0)" ::: "memory"); \
            SA_PV8(0, 4 * (tp)); SA_PV8(4096, 4 * (tp) + 1); SA_PV8(8192, 4 * (tp) + 2); SA_PV8(12288, 4 * (tp) + 3); \
            LDS_WAIT(); asm volatile("" ::: "memory"); __builtin_amdgcn_sched_barrier(0); } while (0)
        SA_VSTAGE8(0); SA_VSTAGE8(1);
#undef SA_VSTAGE8
#undef SA_PV8
#undef SA_TR8
#else
        SA_VSTAGE(0); SA_VSTAGE(1); SA_VSTAGE(2); SA_VSTAGE(3);
#endif
        const float inv = 1.0f / sum;
        if (c < 4) {
#if OUT_FP8
            unsigned char* op = (unsigned char*)MIX + (size_t)m * MIXB + (OUT_I8P ? 2048 : 0) + (4 * kvh + c) * 128 + 4 * g;
            const float inv16 = inv * 16.0f;
#pragma unroll
            for (int db = 0; db < 8; ++db) { int w = __builtin_amdgcn_cvt_pk_fp8_f32(oacc[db][0] * inv16, oacc[db][1] * inv16, 0, false); w = __builtin_amdgcn_cvt_pk_fp8_f32(oacc[db][2] * inv16, oacc[db][3] * inv16, w, true); *(unsigned*)(op + 16 * db) = (unsigned)w; }
#else
            f16* op = MIX + (size_t)m * DM + (4 * kvh + c) * 128 + 4 * g;
#pragma unroll
            for (int db = 0; db < 8; ++db) { u32x2 w; w.x = pk2t<FFN_BF16 != 0>(oacc[db][0] * inv, oacc[db][1] * inv); w.y = pk2t<FFN_BF16 != 0>(oacc[db][2] * inv, oacc[db][3] * inv); *(u32x2*)(op + 16 * db) = w; }
#endif
        }
    }
#undef SA_KSTAGE
#undef SA_VSTAGE
#undef SA_PV
}

__device__ __forceinline__ void rows2048_quant(const f16* src, unsigned char* dst, int dstride, const float* rmax, int nrows, int gw, int NGW, int lane) {
    for (int m = gw; m < nrows; m += NGW) {
        const float s = 127.0f * __builtin_amdgcn_rcpf(fmaxf(rmax[m], 1e-30f));
        const u32x4* xi = (const u32x4*)(src + (size_t)m * 2048) + lane; u32x2* o = (u32x2*)(dst + (size_t)m * dstride) + lane;
        u32x4 xv[4];
#pragma unroll
        for (int j = 0; j < 4; ++j) xv[j] = xi[64 * j];
        asm volatile("" ::: "memory");
#pragma unroll
        for (int j = 0; j < 4; ++j) { const u32x4 w = xv[j];
            f32x4 a = {__builtin_bit_cast(float, w.x << 16), __builtin_bit_cast(float, w.x & 0xffff0000u), __builtin_bit_cast(float, w.y << 16), __builtin_bit_cast(float, w.y & 0xffff0000u)};
            f32x4 b = {__builtin_bit_cast(float, w.z << 16), __builtin_bit_cast(float, w.z & 0xffff0000u), __builtin_bit_cast(float, w.w << 16), __builtin_bit_cast(float, w.w & 0xffff0000u)};
#pragma unroll
            for (int e = 0; e < 4; ++e) { a[e] = __builtin_amdgcn_fmed3f(a[e] * s, -127.f, 127.f); b[e] = __builtin_amdgcn_fmed3f(b[e] * s, -127.f, 127.f); }
            u32x2 q; q.x = q8x4(a); q.y = q8x4(b); o[64 * j] = q; }
    }
}

__device__ __forceinline__ void x1_quant_phase(const f16* x1, unsigned char* xq, const float* rmax, int vcu, int G, int wave, int lane) {
    const int gw = vcu * NWAVES + wave, NGW = G * NWAVES;
    for (int m = gw; m < M; m += NGW) {
        const float s = 127.0f * __builtin_amdgcn_rcpf(fmaxf(rmax[m], 1e-30f));
        const u32x4* xi = (const u32x4*)(x1 + (size_t)m * DM) + lane; u32x2* o = (u32x2*)(xq + (size_t)m * DM) + lane;
        u32x4 xv[8];
#pragma unroll
        for (int j = 0; j < 8; ++j) xv[j] = xi[64 * j];
        asm volatile("" ::: "memory");
#pragma unroll
        for (int j = 0; j < 8; ++j) { const u32x4 w = xv[j];
            f32x4 a = {__builtin_bit_cast(float, w.x << 16), __builtin_bit_cast(float, w.x & 0xffff0000u), __builtin_bit_cast(float, w.y << 16), __builtin_bit_cast(float, w.y & 0xffff0000u)};
            f32x4 b = {__builtin_bit_cast(float, w.z << 16), __builtin_bit_cast(float, w.z & 0xffff0000u), __builtin_bit_cast(float, w.w << 16), __builtin_bit_cast(float, w.w & 0xffff0000u)};
#pragma unroll
            for (int e = 0; e < 4; ++e) { a[e] = __builtin_amdgcn_fmed3f(a[e] * s, -127.f, 127.f); b[e] = __builtin_amdgcn_fmed3f(b[e] * s, -127.f, 127.f); }
            u32x2 q; q.x = q8x4(a); q.y = q8x4(b); o[64 * j] = q; }
    }
}

__device__ __forceinline__ void final_norm_phase(const f16* x2, float* out, const float* ss3, const float* gf, int vcu, int G, int wave, int lane) {
    const int gw = vcu * NWAVES + wave, NGW = G * NWAVES;
    for (int m = gw; m < M; m += NGW) {
        const float r = 1.0f / sqrtf(ss3[m] * (1.0f / DM) + EPS);
        const f16x8* xi = (const f16x8*)(x2 + (size_t)m * DM) + lane; f32x4* o = (f32x4*)(out + (size_t)m * DM) + 2 * lane; const f32x4* gp = (const f32x4*)gf + 2 * lane;
        f16x8 xv[8]; f32x4 gv[8][2];
#pragma unroll
        for (int j = 0; j < 8; ++j) { xv[j] = xi[64 * j]; gv[j][0] = gp[128 * j]; gv[j][1] = gp[128 * j + 1]; }
        asm volatile("" ::: "memory");
#pragma unroll
        for (int j = 0; j < 8; ++j) { const f16x8 v = xv[j];
            o[128 * j] = (f32x4){(float)v[0], (float)v[1], (float)v[2], (float)v[3]} * r * gv[j][0];
            o[128 * j + 1] = (f32x4){(float)v[4], (float)v[5], (float)v[6], (float)v[7]} * r * gv[j][1]; }
    }
}

__global__ void __launch_bounds__(NWAVES * 64, 2) fwd(Args args) {
    extern __shared__ __attribute__((aligned(16))) unsigned char lds_raw[];
    LAS unsigned char* lds = (LAS unsigned char*)lds_raw;
    volatile LAS unsigned* MISC = (volatile LAS unsigned*)(lds + LDSCTL_OFF + 320);
    const int wave = __builtin_amdgcn_readfirstlane(threadIdx.x >> 6);
#define FRESH_TID() const int tid = fresh_tid(wave); const int lane = tid & 63
    const int G = gridDim.x, bid = blockIdx.x, vcu = (G % 8 == 0) ? (bid % 8) * (G / 8) + bid / 8 : bid;
    unsigned char* ws = args.ws;
    gu32* ctl = (gu32*)(ws + WS_CTL);
    for (int u = fresh_tid(wave); u < (LDS_BYTES - LDSCTL_OFF) / 4; u += NWAVES * 64) ((LAS unsigned*)(lds + LDSCTL_OFF))[u] = 0u;
    __syncthreads();
    XcdBarrier bar; bar.bar = (unsigned*)(ctl + CW_BAR); bar.x = 0; bar.st = nullptr; bar.wave = wave;
    if (MK_N_LAUNCHES == 1) bar = xcd_barrier_post((unsigned*)(ctl + CW_BAR), MISC + 8, wave);
    const int lo = args.ph_lo, hi = args.ph_hi;
#define IN(k) (lo <= (k) && (k) < hi)
#define BOTH(k) (IN(k) && IN((k) + 1))
#define GRID_BAR() do { if (MK_N_LAUNCHES == 1) xcd_barrier(bar); } while (0)
    f16* XH = (f16*)(ws + WS_XH); f16* Qb = (f16*)(ws + WS_Q); f16* Kb = (f16*)(ws + WS_K); f16* Vb = (f16*)(ws + WS_V); f16* IQ = (f16*)(ws + WS_IQ); f16* IK = (f16*)(ws + WS_IK);
    f16* Ub = (f16*)(ws + WS_U); f16* PD = (f16*)(ws + WS_PD); f16* MIX = (f16*)(ws + WS_MIX); f16* Ab = (f16*)(ws + WS_A); float* IW = (float*)(ws + WS_IW); u16* TK = (u16*)(ws + WS_TOPK);
    float* SS2 = (float*)(ws + WS_CTL + CTL_SS2); float* SS3 = (float*)(ws + WS_CTL + CTL_SS3);

    if (IN(0)) { FRESH_TID(); p0_prologue(args, lds, vcu, G, wave, lane);
        if (U_I8) { GRID_BAR(); p0_convert(args, vcu, G, wave, lane); }
        if (BOTH(0)) GRID_BAR(); }
    if (IN(1)) {
        if (QKV_FP8) {
            if (QKV_I8) { pg8::Gemm g{(const char*)(ws + WS_X8I), (const char*)(ws + WS_W8), DM / 2, DM / 2, DM / 2, 0, 0x7f7f7f7fu, (const float*)(ws + WS_CTL + CTL_CMAXQ)}; pg8::StaticOrder S; S.init(M / 256, 12, G, bid);
              EpiInT<1> E{(const float*)(ws + WS_R1X), (const float*)(ws + WS_COSA), (const float*)(ws + WS_SINA), (const float*)(ws + WS_COSI), (const float*)(ws + WS_SINI), Qb, Kb, Vb, IQ, IK, Ub, IW, 0, 1.0f};
              pg8::gemm_phase<EpiInT<1>, false, true, false, false, 0, true>(lds, g, S, E, wave); }
            else { pg8::Gemm g{(const char*)(ws + WS_X8), (const char*)(ws + WS_W8), DM / 2, DM / 2, DM / 2, 0}; pg8::StaticOrder S; S.init(M / 256, 12, G, bid);
              EpiInT<1> E{(const float*)(ws + WS_R1), (const float*)(ws + WS_COSA), (const float*)(ws + WS_SINA), (const float*)(ws + WS_COSI), (const float*)(ws + WS_SINI), Qb, Kb, Vb, IQ, IK, Ub, IW, 0, 1.0f / 64.0f};
              pg8::gemm_phase<EpiInT<1>, false, true, false, false, pg8::F8_ALL>(lds, g, S, E, wave); }
            if (U_I8) { pg8::Gemm g{(const char*)(ws + WS_X8I), (const char*)(ws + WS_W8I), DM / 2, DM / 2, DM / 2, 0}; pg8::StaticOrder S; S.init(M / 256, 8, G, bid);
              EpiU8 E{(const float*)(ws + WS_R1), (const float*)(ws + WS_XMAX), (const float*)(ws + WS_CTL + CTL_CMAXU), Ub};
              pg8::gemm_phase<EpiU8, false, true, false, false, 0, true>(lds, g, S, E, wave); }
            { pg8::Gemm g{(const char*)XH, (const char*)(ws + WS_WIN) + (size_t)3072 * DM * 2, DM, DM, DM, 0}; pg8::StaticOrder S; S.init(M / 256, U_I8 ? 4 : 12, G, bid);
              EpiIn E{(const float*)(ws + WS_R1), (const float*)(ws + WS_COSA), (const float*)(ws + WS_SINA), (const float*)(ws + WS_COSI), (const float*)(ws + WS_SINI), Qb, Kb, Vb, IQ, IK, Ub, IW, 12, 1.0f};
              pg8::gemm_phase<EpiIn>(lds, g, S, E, wave); }
        } else {
        pg8::Gemm g{(const char*)XH, (const char*)(ws + WS_WIN), DM, DM, DM, 0}; pg8::StaticOrder S; S.init(M / 256, 24, G, bid);
        EpiIn E{(const float*)(ws + WS_R1), (const float*)(ws + WS_COSA), (const float*)(ws + WS_SINA), (const float*)(ws + WS_COSI), (const float*)(ws + WS_SINI), Qb, Kb, Vb, IQ, IK, Ub, IW, 0, 1.0f};
        pg8::gemm_phase<EpiIn>(lds, g, S, E, wave);
        }
        if (BOTH(1)) GRID_BAR();
    }
    if (IN(2)) {
        FRESH_TID();
        const bool split = (G % 4 == 0) && G >= 64;
        if (!split || (bid & 3) == 0) {
            pg8::Gemm g{(const char*)XH, (const char*)(ws + WS_WIN), DM, DM, DM, 0}; pg8::StaticOrder S; S.init(M / 256, 25, split ? G / 4 : G, split ? bid >> 2 : bid, 24);
            EpiIn E{(const float*)(ws + WS_R1), (const float*)(ws + WS_COSA), (const float*)(ws + WS_SINA), (const float*)(ws + WS_COSI), (const float*)(ws + WS_SINI), Qb, Kb, Vb, IQ, IK, Ub, IW, 0, 1.0f};
            pg8::gemm_phase<EpiIn, false, true, false, true>(lds, g, S, E, wave);
        }
        const size_t npd = (size_t)M * 256, cut = npd / 16 * 15;
        f16* pdd = OUT_I8P ? (f16*)(ws + WS_DIFFB) : POOL_FOLD ? MIX : PD;
        float* dmx = OUT_I8P ? (float*)(ws + WS_CTL + CTL_DMAX) : nullptr;
        if (!split) { if (OUT_I8P) pool_diff_rows_i8(Ub, (unsigned char*)MIX, dmx, bid * NWAVES + wave, G * NWAVES, lane, 0, M); else pool_diff_phase<POOL_FOLD != 0>(Ub, pdd, bid, G, tid, 0, (size_t)M * 256, dmx); }
        else if ((bid & 3) != 0) { const int vi = (bid >> 2) * 3 + (bid & 3) - 1, nv = (G / 4) * 3;
            if (OUT_I8P) pool_diff_rows_i8(Ub, (unsigned char*)MIX, dmx, vi * NWAVES + wave, nv * NWAVES, lane, 0, M / 16 * 15);
            else pool_diff_phase<POOL_FOLD != 0>(Ub, pdd, vi, nv, tid, 0, cut, dmx);
            if (CMF_SPLIT && GU_I8) colmax_ffn(args, 43 * 32, 2 * 43 * 32, vi * NWAVES + wave, nv * NWAVES, lane);
            else for (int it = vi * NWAVES + wave; it < P2_CV_ROUNDS * nv * NWAVES; it += nv * NWAVES) { CvJob cj; f32x4 v[8]; float gs[8]; cv32_job(args, it, lane, cj); cv32_issue(v, gs, cj, lane, (const float*)(ws + WS_CTL + CTL_CMAX));
                asm volatile("" :: "v"(cj.qs)); if (GU_I8 && cj.bf == 3) cv32_finish_i8(v, gs, cj); else if (FFN_F8K && cj.bf == 2) cv32_finish_f8(v, gs, cj); else cv32_finish<FFN_BF16 != 0>(v, gs, cj); }
        }
        else if (OUT_I8P) pool_diff_rows_i8(Ub, (unsigned char*)MIX, dmx, (bid >> 2) * NWAVES + wave, (G / 4) * NWAVES, lane, M / 16 * 15, M);
        else pool_diff_phase<POOL_FOLD != 0>(Ub, pdd, bid >> 2, G / 4, tid, cut, npd, dmx);
        if (BOTH(2)) GRID_BAR();
    }
    if (IN(3)) {
        FRESH_TID();
        indexer_phase(args, IQ, IK, IW, TK, lds, bid, G, tid, wave, lane, (CMF_SPLIT && GU_I8) ? 0 : P2_CV_ROUNDS * (((G % 4 == 0) && G >= 64) ? (G / 4) * 3 * NWAVES : 0));
        if (PROBE_REP == 21) indexer_phase(args, IQ, IK, IW, TK, lds, bid, G, tid, wave, lane);
        if (PROBE_REP == 23) indexer_phase<1>(args, IQ, IK, IW, (u16*)(ws + WS_MIX), lds, bid, G, tid, wave, lane);
        if (PROBE_REP == 24) indexer_phase<2>(args, IQ, IK, IW, (u16*)(ws + WS_MIX), lds, bid, G, tid, wave, lane);
        if (PROBE_REP == 25) indexer_phase<3>(args, IQ, IK, IW, (u16*)(ws + WS_MIX), lds, bid, G, tid, wave, lane);
        if (BOTH(3)) GRID_BAR();
    }
    if (IN(4)) {
        FRESH_TID();
        if (POOL_FOLD) {
            pg8::Gemm g{(const char*)(ws + WS_WORAW), (const char*)(ws + WS_WPOOL), 2048, 512, 512, 1}; pg8::StaticOrder S; S.init(DM / 256, 8, G, bid);
            EpiPool E{nullptr, OUT_I8P ? (f16*)(ws + WS_WPB) : (f16*)(ws + WS_WOUT), OUT_I8P ? (float*)(ws + WS_CTL + CTL_WPMAX) : nullptr}; pg8::gemm_phase<EpiPool, FFN_BF16 != 0>(lds, g, S, E, wave);
        } else
        { pg8::Gemm g{(const char*)PD, (const char*)(ws + WS_WPOOL), NU, 512, 512, 1}; pg8::StaticOrder S; S.init(M / 256, 8, G, bid);
          EpiPool E{args.in[4], MIX, nullptr}; pg8::gemm_phase<EpiPool>(lds, g, S, E, wave); if (PROBE_REP == 30) pg8::gemm_phase<EpiPool>(lds, g, S, E, wave); }
        LAS unsigned* qctr = (LAS unsigned*)(lds + LDSCTL_OFF + 320 + 64);
        if (tid == 0) *qctr = 0u;
        __syncthreads();
        sparse_attn_phase(args, Qb, Kb, Vb, TK, MIX, lds, qctr, bid, G, wave, lane);
        if (PROBE_REP == 31) { __syncthreads(); if (tid == 0) *qctr = 0u; __syncthreads(); sparse_attn_phase(args, Qb, Kb, Vb, TK, MIX, lds, qctr, bid, G, wave, lane); }
        if (BOTH(4)) GRID_BAR();
    }
    if (IN(5)) {
        if (OUT_I8P) {
            FRESH_TID(); const int gw = vcu * NWAVES + wave, NGW = G * NWAVES;
            rows2048_quant((const f16*)(ws + WS_WPB), ws + WS_WOUT, MIXB, (const float*)(ws + WS_CTL + CTL_WPMAX), DM, gw, NGW, lane);
            GRID_BAR();
        }
        pg8::Gemm g{(const char*)MIX, (const char*)(ws + WS_WOUT), MIXB / 2, MIXB / 2, MIXB / 2, 0, OUT_FP8 ? 0x7a7a7a7au : 0x7f7f7f7fu, OUT_I8P ? (const float*)(ws + WS_CTL + CTL_WPMAX) : nullptr, OUT_I8P ? (const float*)(ws + WS_CTL + CTL_DMAX) : nullptr}; pg8::StaticOrder S; S.init(M / 256, DM / 256, G, bid);
        EpiRes<false, FFN_BF16 != 0, GU_I8 ? 3 : FFN_F8K ? 1 : 0> E{XH, SS2, GU_I8 ? ws + WS_CTL + CTL_RMAX : ws + WS_XA};
        if (OUT_I8P) pg8::gemm_phase<EpiRes<false, FFN_BF16 != 0, GU_I8 ? 3 : FFN_F8K ? 1 : 0>, FFN_BF16 != 0, true, false, false, pg8::F8_ALL, false, 16>(lds, g, S, E, wave);
        else pg8::gemm_phase<EpiRes<false, FFN_BF16 != 0, GU_I8 ? 3 : FFN_F8K ? 1 : 0>, FFN_BF16 != 0, true, false, false, OUT_FP8 ? 16 : 0>(lds, g, S, E, wave);
        if (BOTH(5)) GRID_BAR();
    }
    if (IN(6)) {
        if (GU_I8) { FRESH_TID(); x1_quant_phase(XH, ws + WS_XA, (const float*)(ws + WS_CTL + CTL_RMAX), vcu, G, wave, lane); GRID_BAR(); }
        constexpr int GUK = GU_I8 ? DM / 2 : XAB / 2;
        pg8::Gemm g{(FFN_F8K || GU_I8) ? (const char*)(ws + WS_XA) : (const char*)XH, (const char*)(ws + WS_WGU), GUK, GUK, GUK, 0, FFN_F8K ? 0x7b7b7b7bu : 0x7f7f7f7fu}; pg8::StaticOrder S; S.init(M / 256, NGU / 256, G, bid);
        constexpr int F8T6 = GU_I8 ? 0 : KF6 / 128; constexpr bool I86 = GU_I8 != 0;
        EpiGU E{SS2, Ab, (const float*)(ws + WS_CTL + CTL_RMAX), (const float*)(ws + WS_CTL + CTL_CMAX)};
        const int nfull = S.nwg / G, rest = S.nwg - nfull * G;
        if (rest > 0 && 2 * rest <= G) {
            S.imax = nfull; pg8::gemm_phase<EpiGU, FFN_BF16 != 0, true, false, false, F8T6, I86>(lds, g, S, E, wave);
            pg8::StaticOrder S2; S2.init(M / 256, NGU / 256, G, bid); S2.hbase = nfull * G;
            if (bid < 2 * rest) pg8::gemm_phase<EpiGU, FFN_BF16 != 0, true, true, false, F8T6, I86>(lds, g, S2, E, wave);
        } else pg8::gemm_phase<EpiGU, FFN_BF16 != 0, true, false, false, F8T6, I86>(lds, g, S, E, wave);
        if (BOTH(6)) GRID_BAR();
    }
    if (IN(7)) {
        pg8::Gemm g{(const char*)Ab, (const char*)(ws + WS_WDN), ABB / 2, ABB / 2, ABB / 2, 0, FFN_F8K ? 0x7a7a7a7au : 0x7f7f7f7fu}; pg8::StaticOrder S; S.init(M / 256, DM / 256, G, bid);
        EpiRes<FFN_BF16 != 0, false, (FFN_F8K && !GU_I8) ? 2 : 0> E{XH, SS3, ws + WS_XA};
        pg8::gemm_phase<EpiRes<FFN_BF16 != 0, false, (FFN_F8K && !GU_I8) ? 2 : 0>, FFN_BF16 != 0, true, false, false, (KF7 == DFF ? pg8::F8_ALL : KF7 / 128)>(lds, g, S, E, wave);
        if (BOTH(7)) GRID_BAR();
    }
    if (IN(8)) { FRESH_TID(); final_norm_phase((const f16*)XH, args.out, SS3, args.in[10], vcu, G, wave, lane); }
#undef FRESH_TID
#undef IN
#undef BOTH
#undef GRID_BAR
}

extern "C" void kernel_launch(void* const* d_in, const int* in_sizes, int n_in, void* d_out, int out_size, void* d_ws, size_t ws_size, hipStream_t stream) {
    static int grid = 0;
    if (grid == 0) {
        if (n_in != 11 || in_sizes[0] != M * DM || out_size != M * DM || ws_size < WS_END) { fprintf(stderr, "kernel_launch: unexpected shapes (n_in %d, in0 %d, out %d, ws %zu)\n", n_in, n_in > 0 ? in_sizes[0] : -1, out_size, ws_size); grid = -1; return; }
        int dev = 0, cus = 0, per_cu = 0;
        if (hipGetDevice(&dev) != hipSuccess || hipDeviceGetAttribute(&cus, hipDeviceAttributeMultiprocessorCount, dev) != hipSuccess) { grid = -1; return; }
        if (hipFuncSetAttribute((const void*)fwd, hipFuncAttributeMaxDynamicSharedMemorySize, LDS_BYTES) != hipSuccess) { fprintf(stderr, "kernel_launch: hipFuncSetAttribute failed\n"); grid = -1; return; }
        if (hipOccupancyMaxActiveBlocksPerMultiprocessor(&per_cu, (const void*)fwd, NWAVES * 64, LDS_BYTES) != hipSuccess || per_cu < 1) { fprintf(stderr, "kernel_launch: occupancy query says %d blocks per CU\n", per_cu); per_cu = 1; }
        (void)hipGetLastError();
        grid = cus;
    }
    if (grid < 0) return;
    (void)hipMemsetAsync((char*)d_ws + WS_CTL, 0, CTL_ZERO_BYTES, stream);
    Args a{};
    for (int i = 0; i < 11; ++i) a.in[i] = (const float*)d_in[i];
    a.out = (float*)d_out; a.ws = (unsigned char*)d_ws;
    for (int i = 0; i < 16; ++i) a.invfA[i] = (float)pow(500000.0, -(double)i / 16.0);
    for (int i = 0; i < 8; ++i) a.invfI[i] = (float)pow(500000.0, -(double)i / 8.0);
    constexpr int NPH = 9;
    if (MK_N_LAUNCHES == 1) { a.ph_lo = 0; a.ph_hi = NPH; a.li = 0; hipLaunchKernelGGL(fwd, dim3(grid), dim3(NWAVES * 64), LDS_BYTES, stream, a); }
    else for (int p = 0; p < NPH; ++p) { a.ph_lo = p; a.ph_hi = p + 1; a.li = p; hipLaunchKernelGGL(fwd, dim3(grid), dim3(NWAVES * 64), LDS_BYTES, stream, a); }
}
```
